# Optimizing an MI355X kernel written in HIP

```python
import jax, jax.numpy as jnp
from jax import lax
import numpy as np

D_MODEL = 2048
BATCH = 4
SEQ = 2048
DEPTH = 2
DEC_BATCH = 128
DEC_SEQ = 4
PAST_LEN = 16384
PAGE_SIZE = 128

D_LRU = D_MODEL // 2
D_SC = D_MODEL - D_LRU
D_MIX = D_LRU + D_SC
LRU_HEADS = 8
LRU_HEAD_DIM = D_LRU // LRU_HEADS
SC_GROUPS = 8
LRU_CONV_W = 4
SC_CONV_W = 3
RG_LRU_C = 8.0
D_PLE = 256
IN_SPLITS = (D_LRU, D_LRU, D_SC, D_SC, D_SC, D_SC)
IN_WIDTH = sum(IN_SPLITS)
DEEPNORM_ALPHA = (2.0 * DEPTH) ** 0.25
DEEPNORM_BETA = (8.0 * DEPTH) ** -0.25
LN_EPS = 1e-5
GN_EPS = 1e-6

kernel_name = 'hybrid_rglru_shortconv_deepnorm_step'


def causal_dwconv(x, buf, w):
    k_width = w.shape[0]
    t_len = x.shape[1]
    xp = jnp.concatenate([buf.astype(x.dtype), x], axis=1)
    y = sum(xp[:, k:k + t_len] * w[k] for k in range(k_width))
    return y, xp[:, -(k_width - 1):]


def group_rmsnorm(y, g, n_groups):
    b, t, c = y.shape
    yf = y.astype(jnp.float32).reshape(b, t, n_groups, c // n_groups)
    yf = yf * lax.rsqrt(jnp.mean(yf * yf, axis=-1, keepdims=True) + GN_EPS)
    return (yf.reshape(b, t, c) * g.astype(jnp.float32)).astype(y.dtype)


def layer_norm(x, g, b):
    xf = x.astype(jnp.float32)
    mu = jnp.mean(xf, axis=-1, keepdims=True)
    var = jnp.mean(jnp.square(xf - mu), axis=-1, keepdims=True)
    y = (xf - mu) * lax.rsqrt(var + LN_EPS)
    return (y * g.astype(jnp.float32) + b.astype(jnp.float32)).astype(x.dtype)


def rg_lru(xc, w_a, b_a, w_x, b_x, lam, h0):
    b, t, c = xc.shape
    xh = xc.reshape(b, t, LRU_HEADS, LRU_HEAD_DIM)
    r = jax.nn.sigmoid(jnp.einsum('bthi,hij->bthj', xh, w_a) + b_a).reshape(b, t, c)
    i = jax.nn.sigmoid(jnp.einsum('bthi,hij->bthj', xh, w_x) + b_x).reshape(b, t, c)
    log_a = -RG_LRU_C * r.astype(jnp.float32) * jax.nn.softplus(-lam.astype(jnp.float32))
    a = jnp.exp(log_a)
    mult = jnp.sqrt(jnp.maximum(-jnp.expm1(2.0 * log_a), 0.0))
    u = mult * (i * xc).astype(jnp.float32)

    def step(h, au):
        a_t, u_t = au
        h = a_t * h + u_t
        return h, h

    h_last, hs = lax.scan(step, h0.astype(jnp.float32),
                          (jnp.swapaxes(a, 0, 1), jnp.swapaxes(u, 0, 1)))
    return jnp.swapaxes(hs, 0, 1).astype(xc.dtype), h_last.astype(h0.dtype)


def hybrid_layer(x, p, h0, lbuf, sbuf, w_in, lru_conv_w, lru_conv_b, lru_wa, lru_ba,
                 lru_wx, lru_bx, lru_lambda, sc_conv_w, gn_lru, gn_sc, w_out,
                 ple_wp, ple_wg, ple_bg, ln_g, ln_b):
    z = jnp.einsum('btd,de->bte', x, w_in)
    x_l, g_l, b_s, c_s, h_s, g_s = jnp.split(z, np.cumsum(IN_SPLITS)[:-1].tolist(), axis=-1)
    xc, lbuf_new = causal_dwconv(x_l, lbuf, lru_conv_w)
    xc = xc + lru_conv_b
    hs, h_last = rg_lru(xc, lru_wa, lru_ba, lru_wx, lru_bx, lru_lambda, h0)
    y_l = hs * jax.nn.silu(g_l)
    v, sbuf_new = causal_dwconv(c_s * h_s, sbuf, sc_conv_w)
    y_s = b_s * v * jax.nn.silu(g_s)
    y = jnp.concatenate([group_rmsnorm(y_l, gn_lru, LRU_HEADS),
                         group_rmsnorm(y_s, gn_sc, SC_GROUPS)], axis=-1)
    m = jnp.einsum('bte,ed->btd', y, w_out)
    r = DEEPNORM_ALPHA * x + m
    e = jnp.einsum('btk,kd->btd', p, ple_wp)
    gate = jax.nn.sigmoid(jnp.einsum('btd,de->bte', r, ple_wg) + ple_bg)
    x_new = layer_norm(r + gate * e, ln_g, ln_b)
    return x_new, h_last, lbuf_new, sbuf_new


def run_trunk(x, p, h0s, lbufs, sbufs, w_in, lru_conv_w, lru_conv_b, lru_wa, lru_ba,
              lru_wx, lru_bx, lru_lambda, sc_conv_w, gn_lru, gn_sc, w_out,
              ple_wp, ple_wg, ple_bg, ln_g, ln_b):
    hs, lbs, sbs = [], [], []
    for l in range(DEPTH):
        x, h_new, lb_new, sb_new = hybrid_layer(
            x, p[l], h0s[l], lbufs[l], sbufs[l], w_in[l], lru_conv_w[l], lru_conv_b[l],
            lru_wa[l], lru_ba[l], lru_wx[l], lru_bx[l], lru_lambda[l], sc_conv_w[l],
            gn_lru[l], gn_sc[l], w_out[l], ple_wp[l], ple_wg[l], ple_bg[l], ln_g[l], ln_b[l])
        hs.append(h_new)
        lbs.append(lb_new)
        sbs.append(sb_new)
    return x, jnp.stack(hs), jnp.stack(lbs), jnp.stack(sbs)


def setup_inputs(seed: int = 0) -> dict:
    key = jax.random.key(seed)
    ks = jax.random.split(key, 24)
    f32 = jnp.float32

    def nrm(k, shape, scale):
        return jax.random.normal(k, shape, f32) * scale

    a0 = jax.random.uniform(ks[14], (DEPTH, D_LRU), f32, 0.9, 0.999)
    a_base = a0 ** (1.0 / RG_LRU_C)
    return {
        'x_prompt': nrm(ks[0], (BATCH, SEQ, D_MODEL), 1.0),
        'x_sample': nrm(ks[1], (DEC_BATCH, DEC_SEQ, D_MODEL), 1.0),
        'state_lru_h': nrm(ks[2], (DEPTH, DEC_BATCH, D_LRU), 0.5),
        'state_lru_conv': nrm(ks[3], (DEPTH, DEC_BATCH, LRU_CONV_W - 1, D_LRU), 1.0),
        'state_sc_conv': nrm(ks[4], (DEPTH, DEC_BATCH, SC_CONV_W - 1, D_SC), 1.0),
        'p_prompt': nrm(ks[5], (DEPTH, BATCH, SEQ, D_PLE), 1.0),
        'p_sample': nrm(ks[6], (DEPTH, DEC_BATCH, DEC_SEQ, D_PLE), 1.0),
        'w_in': nrm(ks[7], (DEPTH, D_MODEL, IN_WIDTH), D_MODEL ** -0.5),
        'lru_conv_w': nrm(ks[8], (DEPTH, LRU_CONV_W, D_LRU), LRU_CONV_W ** -0.5),
        'lru_conv_b': nrm(ks[9], (DEPTH, D_LRU), 0.01),
        'lru_wa': nrm(ks[10], (DEPTH, LRU_HEADS, LRU_HEAD_DIM, LRU_HEAD_DIM), LRU_HEAD_DIM ** -0.5),
        'lru_ba': nrm(ks[11], (DEPTH, LRU_HEADS, LRU_HEAD_DIM), 0.01),
        'lru_wx': nrm(ks[12], (DEPTH, LRU_HEADS, LRU_HEAD_DIM, LRU_HEAD_DIM), LRU_HEAD_DIM ** -0.5),
        'lru_bx': nrm(ks[13], (DEPTH, LRU_HEADS, LRU_HEAD_DIM), 0.01),
        'lru_lambda': jnp.log(a_base) - jnp.log1p(-a_base),
        'sc_conv_w': nrm(ks[15], (DEPTH, SC_CONV_W, D_SC), SC_CONV_W ** -0.5),
        'gn_lru': 1.0 + nrm(ks[16], (DEPTH, D_LRU), 0.01),
        'gn_sc': 1.0 + nrm(ks[17], (DEPTH, D_SC), 0.01),
        'w_out': nrm(ks[18], (DEPTH, D_MIX, D_MODEL), (D_MIX ** -0.5) * DEEPNORM_BETA),
        'ple_wp': nrm(ks[19], (DEPTH, D_PLE, D_MODEL), D_PLE ** -0.5),
        'ple_wg': nrm(ks[20], (DEPTH, D_MODEL, D_MODEL), D_MODEL ** -0.5),
        'ple_bg': nrm(ks[21], (DEPTH, D_MODEL), 0.01),
        'ln_g': 1.0 + nrm(ks[22], (DEPTH, D_MODEL), 0.01),
        'ln_b': nrm(ks[23], (DEPTH, D_MODEL), 0.01),
    }


def reference(x_prompt, x_sample, state_lru_h, state_lru_conv, state_sc_conv, p_prompt, p_sample,
              w_in, lru_conv_w, lru_conv_b, lru_wa, lru_ba, lru_wx, lru_bx, lru_lambda,
              sc_conv_w, gn_lru, gn_sc, w_out, ple_wp, ple_wg, ple_bg, ln_g, ln_b):
    dt = x_prompt.dtype
    h0_p = jnp.zeros((DEPTH, BATCH, D_LRU), dt)
    lb_p = jnp.zeros((DEPTH, BATCH, LRU_CONV_W - 1, D_LRU), dt)
    sb_p = jnp.zeros((DEPTH, BATCH, SC_CONV_W - 1, D_SC), dt)
    y_prompt, lru_h_prompt, lru_conv_prompt, sc_conv_prompt = run_trunk(
        x_prompt, p_prompt, h0_p, lb_p, sb_p, w_in, lru_conv_w, lru_conv_b, lru_wa, lru_ba,
        lru_wx, lru_bx, lru_lambda, sc_conv_w, gn_lru, gn_sc, w_out, ple_wp, ple_wg, ple_bg,
        ln_g, ln_b)
    y_sample, lru_h_sample, lru_conv_sample, sc_conv_sample = run_trunk(
        x_sample, p_sample, state_lru_h, state_lru_conv, state_sc_conv, w_in, lru_conv_w,
        lru_conv_b, lru_wa, lru_ba, lru_wx, lru_bx, lru_lambda, sc_conv_w, gn_lru, gn_sc,
        w_out, ple_wp, ple_wg, ple_bg, ln_g, ln_b)
    return (y_prompt, y_sample, lru_h_prompt, lru_conv_prompt, sc_conv_prompt,
            lru_h_sample, lru_conv_sample, sc_conv_sample)
```

```cpp
#include <hip/hip_runtime.h>
#include <hip/hip_cooperative_groups.h>
#include <cstdio>
namespace cg = cooperative_groups;

#define LAS __attribute__((address_space(3)))
typedef unsigned short bf16_t;
typedef short bf16x8 __attribute__((ext_vector_type(8)));
typedef float f32x4 __attribute__((ext_vector_type(4)));
typedef unsigned u32x4 __attribute__((ext_vector_type(4)));
typedef unsigned u32x2 __attribute__((ext_vector_type(2)));

constexpr int DM = 2048, NPR = 8192, NSR = 512, MT = 8704, NLAYER = 2, DL = 1024, NIN = 6144, DPLE = 256, SEQ = 2048, NB = 4, DB = 128;
constexpr float ALPHA = 1.4142135623730951f;
constexpr size_t O_Y = 0, O_LH_P = (size_t)MT * DM, O_LC_P = O_LH_P + 2 * 4 * 1024, O_SC_P = O_LC_P + 2 * 4 * 3 * 1024,
                 O_LH_S = O_SC_P + 2 * 4 * 2 * 1024, O_LC_S = O_LH_S + 2 * 128 * 1024, O_SC_S = O_LC_S + 2 * 128 * 3 * 1024;
constexpr size_t SZ_ACT = (size_t)MT * DM * 2;
constexpr size_t WS_XB = 0, WS_PB = WS_XB + SZ_ACT, WS_WIN = WS_PB + (size_t)2 * MT * 256 * 2, WS_WOUT = WS_WIN + (size_t)2 * NIN * DM * 2,
                 WS_WG = WS_WOUT + (size_t)2 * DM * DM * 2, WS_WP = WS_WG + (size_t)2 * DM * DM * 2, WS_WA = WS_WP + (size_t)2 * DM * 256 * 2,
                 WS_WX = WS_WA + 524288, WS_SUM = WS_WX + 524288, WS_Z = WS_SUM + 1048576, WS_HL = WS_Z + (size_t)MT * NIN * 2,
                 WS_PP = WS_HL + SZ_ACT, WS_YMIX = WS_PP + SZ_ACT, WS_E = WS_YMIX + SZ_ACT, WS_BAR = WS_E + SZ_ACT, WS_END = WS_BAR + 16384;
constexpr size_t WS_RB = WS_HL;

struct Params { const float* in[24]; float* out; unsigned char* ws; int ph_lo, ph_hi; };

__device__ __forceinline__ unsigned cvt_pk_bf16(float lo, float hi) { unsigned r; asm volatile("v_cvt_pk_bf16_f32 %0, %1, %2" : "=v"(r) : "v"(lo), "v"(hi)); return r; }
__device__ __forceinline__ float bf_lo(unsigned w) { return __uint_as_float(w << 16); }
__device__ __forceinline__ float bf_hi(unsigned w) { return __uint_as_float(w & 0xffff0000u); }
__device__ __forceinline__ float sigmoidf_(float x) { return 1.0f / (1.0f + __expf(-x)); }
__device__ __forceinline__ u32x4 pack8(const f32x4 a, const f32x4 b) { u32x4 w; w.x = cvt_pk_bf16(a[0], a[1]); w.y = cvt_pk_bf16(a[2], a[3]); w.z = cvt_pk_bf16(b[0], b[1]); w.w = cvt_pk_bf16(b[2], b[3]); return w; }
__device__ __forceinline__ void unpack8_(const u32x4 q, f32x4& lo, f32x4& hi) { lo = (f32x4){bf_lo(q[0]), bf_hi(q[0]), bf_lo(q[1]), bf_hi(q[1])}; hi = (f32x4){bf_lo(q[2]), bf_hi(q[2]), bf_lo(q[3]), bf_hi(q[3])}; }
#define UNPACK8(q_, lo_, hi_) unpack8_(q_, lo_, hi_)

namespace pg8 {
constexpr int BM = 256, BK = 64, HALF = 128, HTB = HALF * BK * 2, STAGE_BYTES = 8 * HTB, NXCD = 8, WGM = 8;
__host__ __device__ __forceinline__ int lds_byte(int r, int c) { const int st = (r >> 4) * 2 + (c >> 5), rr = r & 15, cc = c & 31, ob = rr * 64 + cc * 2; return st * 1024 + (ob ^ (((ob >> 9) & 1) << 5)); }
__host__ __device__ __forceinline__ void stage_rc(int b, int& R, int& C) { const int st = b / 1024, sb = b % 1024, swz = sb ^ (((sb >> 9) & 1) << 5); R = (st >> 1) * 16 + swz / 64; C = (st & 1) * 32 + (swz % 64) / 2; }
__host__ __device__ __forceinline__ int perm32(int rho) { const int n = rho >> 4, i = rho & 15; return 8 * (i >> 2) + 4 * n + (i & 3); }
struct Unit { int pm, pn; };
struct Gemm { const bf16_t* A; const bf16_t* Bt; int M, N, K; };
struct StaticOrder {
    int nM, nN, nwg, G, c;
    __device__ void init(int M, int N, int G_, int c_) { nM = M / BM; nN = N / BM; nwg = nM * nN; G = G_; c = c_; }
    __device__ bool next(int i, Unit& u) const {
        const long L = (long)i * G + c; if (L >= nwg || c < 0) return false;
        int wgid = (int)L; { const int q = nwg / NXCD, r = nwg % NXCD, xcd = wgid % NXCD, off = wgid / NXCD; wgid = (xcd < r ? xcd * (q + 1) : r * (q + 1) + (xcd - r) * q) + off; }
        const int nig = WGM * nN, gid = wgid / nig, fm = gid * WGM, gsz = (nM - fm) < WGM ? (nM - fm) : WGM;
        u.pm = fm + ((wgid % nig) % gsz); u.pn = (wgid % nig) / gsz; return true;
    }
};
struct EpiBf16 {
    bf16_t* O; int ldc;
    __device__ __forceinline__ void operator()(const f32x4 (&acc)[2][2][4][2], const Unit& u, int wr, int wc, int fr, int fq) const {
        const int row0 = u.pm * BM + wr * 64 + fr, col0 = u.pn * BM + wc * 32 + 8 * fq;
#pragma unroll
        for (int ai = 0; ai < 2; ++ai)
#pragma unroll
            for (int m = 0; m < 4; ++m) { bf16_t* rowp = O + (size_t)(row0 + ai * HALF + m * 16) * ldc + col0;
#pragma unroll
                for (int bj = 0; bj < 2; ++bj) *(u32x4*)(rowp + bj * HALF) = pack8(acc[ai][bj][m][0], acc[ai][bj][m][1]); }
    }
};
struct EpiRes {
    const float* xp; const float* xs; float* r32; bf16_t* rb;
    __device__ __forceinline__ void operator()(const f32x4 (&acc)[2][2][4][2], const Unit& u, int wr, int wc, int fr, int fq) const {
        const int row0 = u.pm * BM + wr * 64 + fr, col0 = u.pn * BM + wc * 32 + 8 * fq;
        const float* xbase = (u.pm * BM < NPR) ? xp : xs - (size_t)NPR * DM;
#pragma unroll
        for (int ai = 0; ai < 2; ++ai)
#pragma unroll
            for (int m = 0; m < 4; ++m) { const size_t off = (size_t)(row0 + ai * HALF + m * 16) * DM + col0;
#pragma unroll
                for (int bj = 0; bj < 2; ++bj) {
                    const f32x4 x0 = *(const f32x4*)(xbase + off + bj * HALF), x1 = *(const f32x4*)(xbase + off + bj * HALF + 4);
                    const f32x4 v0 = acc[ai][bj][m][0] + ALPHA * x0, v1 = acc[ai][bj][m][1] + ALPHA * x1;
                    *(f32x4*)(r32 + off + bj * HALF) = v0; *(f32x4*)(r32 + off + bj * HALF + 4) = v1;
                    *(u32x4*)(rb + off + bj * HALF) = pack8(v0, v1); }
                asm volatile("" ::: "memory"); }
    }
};
struct EpiGate {
    float* r32; const bf16_t* e; const float* bg;
    __device__ __forceinline__ void operator()(const f32x4 (&acc)[2][2][4][2], const Unit& u, int wr, int wc, int fr, int fq) const {
        const int row0 = u.pm * BM + wr * 64 + fr, col0 = u.pn * BM + wc * 32 + 8 * fq;
        f32x4 bv[2][2];
#pragma unroll
        for (int bj = 0; bj < 2; ++bj)
#pragma unroll
            for (int n = 0; n < 2; ++n) bv[bj][n] = *(const f32x4*)(bg + col0 + bj * HALF + 4 * n);
#pragma unroll
        for (int ai = 0; ai < 2; ++ai)
#pragma unroll
            for (int m = 0; m < 4; ++m) { const size_t off = (size_t)(row0 + ai * HALF + m * 16) * DM + col0;
#pragma unroll
                for (int bj = 0; bj < 2; ++bj) {
                    const f32x4 r0 = *(const f32x4*)(r32 + off + bj * HALF), r1 = *(const f32x4*)(r32 + off + bj * HALF + 4);
                    const u32x4 ew = *(const u32x4*)(e + off + bj * HALF); f32x4 e0, e1; UNPACK8(ew, e0, e1);
                    f32x4 g0 = acc[ai][bj][m][0] + bv[bj][0], g1 = acc[ai][bj][m][1] + bv[bj][1];
#pragma unroll
                    for (int j = 0; j < 4; ++j) { g0[j] = sigmoidf_(g0[j]); g1[j] = sigmoidf_(g1[j]); }
                    *(f32x4*)(r32 + off + bj * HALF) = r0 + g0 * e0; *(f32x4*)(r32 + off + bj * HALF + 4) = r1 + g1 * e1; }
                asm volatile("" ::: "memory"); }
    }
};

template <class Epi, class Sched>
__device__ __forceinline__ void gemm_phase(LAS unsigned char* lds, const Gemm g, const Sched& S, const Epi& E) {
    int tid_ = threadIdx.x; asm volatile("" : "+v"(tid_));
    const int tid = tid_, wid = __builtin_amdgcn_readfirstlane(tid >> 6), lane = tid & 63, wr = wid >> 2, wc = wid & 3, fr = lane & 15, fq = lane >> 4;
    const int K = g.K, nt = K / BK;
    unsigned voffA[2], voffB[2];
#pragma unroll
    for (int i = 0; i < 2; ++i) { int R, C; stage_rc(tid * 16 + i * 8192, R, C); const int Rb = (R & ~31) + perm32(R & 31);
        voffA[i] = (unsigned)(R * K + C) * 2u; voffB[i] = (unsigned)(Rb * K + C) * 2u; }
    const size_t kstep = (size_t)(BK * 2);
    const size_t hstep = (size_t)HALF * K * 2;
    const size_t tstep = 2 * hstep;
    const unsigned ldsw = (unsigned)wid * 1024u;
    const int aoff = lds_byte(wr * 64 + fr, fq * 8), boff = lds_byte(wc * 32 + fr, fq * 8);
#define PG8_SA(b, h) (((b) * 2 + (h)) * HTB)
#define PG8_SB(b, h) ((4 + (b) * 2 + (h)) * HTB)
#define PG8_STAGE(bufoff, gbase, voff) do { _Pragma("unroll") for (int _i = 0; _i < 2; ++_i) \
        __builtin_amdgcn_global_load_lds((const unsigned*)((const char*)(gbase) + (voff)[_i]), (LAS unsigned*)(lds + (bufoff) + ldsw + _i * 8192), 16, 0, 0); } while (0)
#define PG8_LDA(dst, b, h) do { _Pragma("unroll") for (int m = 0; m < 4; ++m) _Pragma("unroll") for (int k = 0; k < 2; ++k) dst[m][k] = *(const LAS bf16x8*)(lds + PG8_SA(b, h) + aoff + m * 2048 + k * 1024); } while (0)
#define PG8_LDB(dst, b, h) do { _Pragma("unroll") for (int n = 0; n < 2; ++n) _Pragma("unroll") for (int k = 0; k < 2; ++k) dst[n][k] = *(const LAS bf16x8*)(lds + PG8_SB(b, h) + boff + n * 2048 + k * 1024); } while (0)
#define PG8_MMA(ai, bj, At, Bt) do { __builtin_amdgcn_s_setprio(1); _Pragma("unroll") for (int m = 0; m < 4; ++m) _Pragma("unroll") for (int n = 0; n < 2; ++n) _Pragma("unroll") for (int k = 0; k < 2; ++k) \
        acc[ai][bj][m][n] = __builtin_amdgcn_mfma_f32_16x16x32_bf16(Bt[n][k], At[m][k], acc[ai][bj][m][n], 0, 0, 0); __builtin_amdgcn_s_setprio(0); } while (0)
#define PG8_WAIT_V(n) asm volatile("s_waitcnt vmcnt(" #n ")" ::: "memory")
#define PG8_WAIT_L(n) asm volatile("s_waitcnt lgkmcnt(" #n ")" ::: "memory")
#define PG8_BAR __builtin_amdgcn_s_barrier()
#define PG8_SCHED __builtin_amdgcn_sched_barrier(0)
    Unit cur, nxt; int ui = 0;
    if (!S.next(0, cur)) return;
    f32x4 acc[2][2][4][2];
#pragma unroll
    for (int a = 0; a < 2; ++a)
#pragma unroll
        for (int b = 0; b < 2; ++b)
#pragma unroll
            for (int m = 0; m < 4; ++m)
#pragma unroll
                for (int n = 0; n < 2; ++n) acc[a][b][m][n] = (f32x4){0.f, 0.f, 0.f, 0.f};
    bf16x8 At[4][2], B0[2][2], B1[2][2];
    const char* cA = (const char*)g.A + (size_t)cur.pm * tstep; const char* cB = (const char*)g.Bt + (size_t)cur.pn * tstep;
    PG8_STAGE(PG8_SB(0, 0), cB, voffB); PG8_STAGE(PG8_SA(0, 0), cA, voffA); PG8_STAGE(PG8_SB(0, 1), cB + hstep, voffB); PG8_STAGE(PG8_SA(0, 1), cA + hstep, voffA);
    if (wr == 1) PG8_BAR;
    PG8_WAIT_V(4); PG8_BAR;
    PG8_STAGE(PG8_SB(1, 0), cB + kstep, voffB); PG8_STAGE(PG8_SA(1, 0), cA + kstep, voffA); PG8_STAGE(PG8_SB(1, 1), cB + hstep + kstep, voffB);
    PG8_WAIT_V(6); PG8_BAR;
    for (;;) {
        const bool has_next = S.next(ui + 1, nxt);
        const char* nA = has_next ? (const char*)g.A + (size_t)nxt.pm * tstep : cA; const char* nB = has_next ? (const char*)g.Bt + (size_t)nxt.pn * tstep : cB;
        for (int t = 0; t < nt; t += 2) {
            const bool last = (t == nt - 2);
            const char* a1 = cA + (size_t)(t + 1) * kstep;
            const char* a2 = last ? nA : cA + (size_t)(t + 2) * kstep; const char* b2 = last ? nB : cB + (size_t)(t + 2) * kstep;
            const char* a3 = a2 + kstep; const char* b3 = b2 + kstep;
            PG8_LDB(B0, 0, 0); PG8_SCHED; PG8_LDA(At, 0, 0); PG8_STAGE(PG8_SA(1, 1), a1 + hstep, voffA);
            PG8_WAIT_L(8); PG8_BAR; PG8_WAIT_L(0); PG8_MMA(0, 0, At, B0); PG8_BAR; PG8_SCHED;
            PG8_LDB(B1, 0, 1); PG8_STAGE(PG8_SB(0, 0), b2, voffB);
            PG8_BAR; PG8_WAIT_L(0); PG8_MMA(0, 1, At, B1); PG8_BAR;
            PG8_LDA(At, 0, 1); PG8_STAGE(PG8_SA(0, 0), a2, voffA);
            PG8_BAR; PG8_WAIT_L(0); PG8_MMA(1, 0, At, B0); PG8_BAR; PG8_SCHED;
            PG8_STAGE(PG8_SB(0, 1), b2 + hstep, voffB);
            PG8_WAIT_V(6); PG8_BAR; PG8_MMA(1, 1, At, B1); PG8_BAR;
            PG8_LDB(B0, 1, 0); PG8_SCHED; PG8_LDA(At, 1, 0); PG8_STAGE(PG8_SA(0, 1), a2 + hstep, voffA);
            PG8_WAIT_L(8); PG8_BAR; PG8_WAIT_L(0); PG8_MMA(0, 0, At, B0); PG8_BAR; PG8_SCHED;
            PG8_LDB(B1, 1, 1); PG8_STAGE(PG8_SB(1, 0), b3, voffB);
            PG8_BAR; PG8_WAIT_L(0); PG8_MMA(0, 1, At, B1); PG8_BAR;
            PG8_LDA(At, 1, 1); PG8_STAGE(PG8_SA(1, 0), a3, voffA);
            PG8_BAR; PG8_WAIT_L(0); PG8_MMA(1, 0, At, B0); PG8_BAR; PG8_SCHED;
            PG8_STAGE(PG8_SB(1, 1), b3 + hstep, voffB);
            PG8_WAIT_V(6); PG8_BAR; PG8_MMA(1, 1, At, B1); PG8_BAR;
        }
        E(acc, cur, wr, wc, fr, fq);
        if (!has_next) break;
#pragma unroll
        for (int a = 0; a < 2; ++a)
#pragma unroll
            for (int b = 0; b < 2; ++b)
#pragma unroll
                for (int m = 0; m < 4; ++m)
#pragma unroll
                    for (int n = 0; n < 2; ++n) acc[a][b][m][n] = (f32x4){0.f, 0.f, 0.f, 0.f};
        cur = nxt; cA = nA; cB = nB; ++ui;
    }
    PG8_WAIT_V(0);
    if (wr == 0) PG8_BAR;
    PG8_BAR;
#undef PG8_SA
#undef PG8_SB
#undef PG8_STAGE
#undef PG8_LDA
#undef PG8_LDB
#undef PG8_MMA
#undef PG8_WAIT_V
#undef PG8_WAIT_L
#undef PG8_BAR
#undef PG8_SCHED
}
}

__device__ __forceinline__ void cvt_rows(const float* __restrict__ srcA, size_t nA8, const float* __restrict__ srcB, size_t nB8, bf16_t* __restrict__ dst) {
    const size_t n8 = nA8 + nB8;
    for (size_t i = (size_t)blockIdx.x * 512 + threadIdx.x; i < n8; i += (size_t)gridDim.x * 512) {
        const float* s = (i < nA8) ? srcA + i * 8 : srcB + (i - nA8) * 8;
        const f32x4 a = *(const f32x4*)s, b = *(const f32x4*)(s + 4);
        *(u32x4*)(dst + i * 8) = pack8(a, b);
    }
}
__device__ __forceinline__ void tr_tile(const float* __restrict__ src, bf16_t* __restrict__ dst, int R, int C, int idx, LAS float* tile) {
    int tid_ = threadIdx.x; asm volatile("" : "+v"(tid_));
    const int tid = tid_, ntc = C >> 6, tr = idx / ntc, tc = idx - tr * ntc;
#pragma unroll
    for (int i = 0; i < 2; ++i) { const int e = tid + 512 * i, row = e >> 4, c4 = e & 15;
        const f32x4 v = *(const f32x4*)(src + (size_t)(tr * 64 + row) * C + tc * 64 + c4 * 4);
#pragma unroll
        for (int j = 0; j < 4; ++j) tile[row * 65 + c4 * 4 + j] = v[j]; }
    __syncthreads();
    { const int cc = tid >> 3, r0 = (tid & 7) * 8; f32x4 a, b;
#pragma unroll
      for (int j = 0; j < 4; ++j) { a[j] = tile[(r0 + j) * 65 + cc]; b[j] = tile[(r0 + 4 + j) * 65 + cc]; }
      *(u32x4*)(dst + (size_t)(tc * 64 + cc) * R + tr * 64 + r0) = pack8(a, b); }
    __syncthreads();
}
__device__ void phase0(const Params& P, LAS unsigned char* lds) {
    unsigned char* ws = P.ws;
    cvt_rows(P.in[0], (size_t)NPR * DM / 8, P.in[1], (size_t)NSR * DM / 8, (bf16_t*)(ws + WS_XB));
    for (int l = 0; l < NLAYER; ++l)
        cvt_rows(P.in[5] + (size_t)l * NPR * DPLE, (size_t)NPR * DPLE / 8, P.in[6] + (size_t)l * NSR * DPLE, (size_t)NSR * DPLE / 8, (bf16_t*)(ws + WS_PB) + (size_t)l * MT * DPLE);
    LAS float* tile = (LAS float*)lds;
    constexpr int T_IN = 32 * 96, T_SQ = 32 * 32, T_WP = 4 * 32, T_HD = 4;
    constexpr int E0 = 2 * T_IN, E1 = E0 + 2 * T_SQ, E2 = E1 + 2 * T_SQ, E3 = E2 + 2 * T_WP, E4 = E3 + 16 * T_HD, E5 = E4 + 16 * T_HD;
    for (int T = blockIdx.x; T < E5; T += gridDim.x) {
        if (T < E0) { const int l = T / T_IN, i = T - l * T_IN; tr_tile(P.in[7] + (size_t)l * DM * NIN, (bf16_t*)(ws + WS_WIN) + (size_t)l * NIN * DM, DM, NIN, i, tile); }
        else if (T < E1) { const int t = T - E0, l = t / T_SQ, i = t - l * T_SQ; tr_tile(P.in[18] + (size_t)l * DM * DM, (bf16_t*)(ws + WS_WOUT) + (size_t)l * DM * DM, DM, DM, i, tile); }
        else if (T < E2) { const int t = T - E1, l = t / T_SQ, i = t - l * T_SQ; tr_tile(P.in[20] + (size_t)l * DM * DM, (bf16_t*)(ws + WS_WG) + (size_t)l * DM * DM, DM, DM, i, tile); }
        else if (T < E3) { const int t = T - E2, l = t / T_WP, i = t - l * T_WP; tr_tile(P.in[19] + (size_t)l * DPLE * DM, (bf16_t*)(ws + WS_WP) + (size_t)l * DM * DPLE, DPLE, DM, i, tile); }
        else if (T < E4) { const int t = T - E3, mtx = t >> 2, i = t & 3; tr_tile(P.in[10] + (size_t)mtx * 16384, (bf16_t*)(ws + WS_WA) + (size_t)mtx * 16384, 128, 128, i, tile); }
        else { const int t = T - E4, mtx = t >> 2, i = t & 3; tr_tile(P.in[12] + (size_t)mtx * 16384, (bf16_t*)(ws + WS_WX) + (size_t)mtx * 16384, 128, 128, i, tile); }
    }
}

constexpr int N_LRU_TILES = 4 * 32 * 8 + 8 * 8;
__device__ void phase2a(const Params& P, int l, LAS unsigned char* lds) {
    int tid_ = threadIdx.x; asm volatile("" : "+v"(tid_));
    const int tid = tid_, lane = tid & 63, wid = tid >> 6, fr = lane & 15, fq = lane >> 4;
    LAS bf16_t* xcA = (LAS bf16_t*)lds;
    LAS float* xcF = (LAS float*)(lds + 17408);
    LAS float* aL = (LAS float*)(lds + 17408 + 33792);
    LAS float* uL = aL + 64 * 128;
    LAS float* subA = uL + 64 * 128;
    LAS float* subH = subA + 512;
    const bf16_t* z = (const bf16_t*)(P.ws + WS_Z);
    float* hlb = (float*)(P.ws + WS_HL); float* ppb = (float*)(P.ws + WS_PP); float* summ = (float*)(P.ws + WS_SUM);
    const float* cw = P.in[8] + (size_t)l * 4 * DL; const float* cb = P.in[9] + (size_t)l * DL;
    for (int tile = blockIdx.x; tile < N_LRU_TILES; tile += gridDim.x) {
        const bool smp = tile >= 1024;
        int b = 0, hd, c;
        if (!smp) { hd = tile & 7; c = (tile >> 3) & 31; b = tile >> 8; } else { const int s = tile - 1024; hd = s & 7; c = s >> 3; }
        const int row0 = smp ? NPR + c * 64 : b * SEQ + c * 64;
        {
            const int g = tid & 15, chl = g * 8, ch0 = hd * 128 + chl;
            f32x4 w[4][2], bias[2];
#pragma unroll
            for (int k = 0; k < 4; ++k) { w[k][0] = *(const f32x4*)(cw + k * DL + ch0); w[k][1] = *(const f32x4*)(cw + k * DL + ch0 + 4); }
            bias[0] = *(const f32x4*)(cb + ch0); bias[1] = *(const f32x4*)(cb + ch0 + 4);
#pragma unroll
            for (int it = 0; it < 2; ++it) {
                const int r = (tid >> 4) + it * 32;
                f32x4 a0 = bias[0], a1 = bias[1];
#pragma unroll
                for (int k = 0; k < 4; ++k) {
                    f32x4 x0, x1; bool have = true, fromz = true; int tt;
                    if (!smp) { tt = c * 64 + r - k; have = tt >= 0; } else { tt = (r & 3) - k; fromz = tt >= 0; }
                    if (!have) { x0 = (f32x4){0.f, 0.f, 0.f, 0.f}; x1 = x0; }
                    else if (fromz) { const u32x4 v = *(const u32x4*)(z + (size_t)(row0 + r - k) * NIN + ch0); UNPACK8(v, x0, x1); }
                    else { const int sq = c * 16 + (r >> 2); const float* sp = P.in[3] + ((size_t)(l * DB + sq) * 3 + (3 + tt)) * DL + ch0; x0 = *(const f32x4*)sp; x1 = *(const f32x4*)(sp + 4); }
                    a0 += w[3 - k][0] * x0; a1 += w[3 - k][1] * x1;
                    if (k == 0) {
                        if (!smp) { if (c == 31 && r >= 61) { float* o = P.out + O_LC_P + ((size_t)(l * NB + b) * 3 + (r - 61)) * DL + ch0; *(f32x4*)o = x0; *(f32x4*)(o + 4) = x1; } }
                        else if ((r & 3) >= 1) { const int sq = c * 16 + (r >> 2); float* o = P.out + O_LC_S + ((size_t)(l * DB + sq) * 3 + ((r & 3) - 1)) * DL + ch0; *(f32x4*)o = x0; *(f32x4*)(o + 4) = x1; }
                    }
                }
                *(LAS f32x4*)(xcF + r * 132 + chl) = a0; *(LAS f32x4*)(xcF + r * 132 + chl + 4) = a1;
                *(LAS u32x4*)(xcA + r * 136 + chl) = pack8(a0, a1);
            }
        }
        __syncthreads();
        {
            const int n0 = wid * 16, chl = n0 + fr, chg = hd * 128 + chl;
            const bf16_t* waT = (const bf16_t*)(P.ws + WS_WA) + ((size_t)((l * 8 + hd) * 128 + chl)) * 128 + fq * 8;
            const bf16_t* wxT = (const bf16_t*)(P.ws + WS_WX) + ((size_t)((l * 8 + hd) * 128 + chl)) * 128 + fq * 8;
            bf16x8 fa[4], fx[4];
#pragma unroll
            for (int kk = 0; kk < 4; ++kk) { fa[kk] = *(const bf16x8*)(waT + kk * 32); fx[kk] = *(const bf16x8*)(wxT + kk * 32); }
            f32x4 accR[4], accI[4];
#pragma unroll
            for (int m = 0; m < 4; ++m) { accR[m] = (f32x4){0.f, 0.f, 0.f, 0.f}; accI[m] = accR[m]; }
#pragma unroll
            for (int m = 0; m < 4; ++m)
#pragma unroll
                for (int kk = 0; kk < 4; ++kk) {
                    const bf16x8 a = *(const LAS bf16x8*)(xcA + (m * 16 + fr) * 136 + kk * 32 + fq * 8);
                    accR[m] = __builtin_amdgcn_mfma_f32_16x16x32_bf16(a, fa[kk], accR[m], 0, 0, 0);
                    accI[m] = __builtin_amdgcn_mfma_f32_16x16x32_bf16(a, fx[kk], accI[m], 0, 0, 0);
                }
            const float ba = P.in[11][l * DL + chg], bx = P.in[13][l * DL + chg], lam = P.in[14][l * DL + chg];
            const float sp = log1pf(expf(-lam));
#pragma unroll
            for (int m = 0; m < 4; ++m)
#pragma unroll
                for (int j = 0; j < 4; ++j) {
                    const int row = m * 16 + fq * 4 + j;
                    const float rr = sigmoidf_(accR[m][j] + ba), ii = sigmoidf_(accI[m][j] + bx);
                    const float la = -8.0f * rr * sp, a = expf(la), mult = sqrtf(fmaxf(-expm1f(2.0f * la), 0.0f));
                    aL[row * 128 + chl] = a; uL[row * 128 + chl] = mult * ii * xcF[row * 132 + chl];
                }
        }
        __syncthreads();
        {
            const int ch = tid & 127, sub = tid >> 7, chg = hd * 128 + ch;
            if (!smp) {
                float h = 0.f, pr = 1.f;
#pragma unroll 4
                for (int s = 0; s < 16; ++s) { const int t = sub * 16 + s; const float a = aL[t * 128 + ch], u = uL[t * 128 + ch]; h = a * h + u; pr *= a; uL[t * 128 + ch] = h; aL[t * 128 + ch] = pr; }
                subA[sub * 128 + ch] = pr; subH[sub * 128 + ch] = h;
                __syncthreads();
                float carry = 0.f, pref = 1.f;
                for (int j = 0; j < sub; ++j) { const float A = subA[j * 128 + ch]; carry = A * carry + subH[j * 128 + ch]; pref *= A; }
#pragma unroll 4
                for (int s = 0; s < 16; ++s) { const int t = sub * 16 + s; const size_t o = (size_t)(row0 + t) * DL + chg;
                    hlb[o] = uL[t * 128 + ch] + aL[t * 128 + ch] * carry; ppb[o] = aL[t * 128 + ch] * pref; }
                if (sub == 3) { const float A3 = subA[3 * 128 + ch]; float* so = summ + ((size_t)(b * 32 + c) * DL + chg) * 2; so[0] = pref * A3; so[1] = A3 * carry + subH[3 * 128 + ch]; }
            } else {
#pragma unroll
                for (int q = 0; q < 4; ++q) { const int sl = sub * 4 + q, sq = c * 16 + sl;
                    float h = P.in[2][(size_t)(l * DB + sq) * DL + chg];
#pragma unroll
                    for (int t = 0; t < 4; ++t) { const int r = sl * 4 + t; h = aL[r * 128 + ch] * h + uL[r * 128 + ch]; const size_t o = (size_t)(row0 + r) * DL + chg; hlb[o] = h; ppb[o] = 0.f; }
                    P.out[O_LH_S + (size_t)(l * DB + sq) * DL + chg] = h; }
            }
        }
        __syncthreads();
    }
}

__device__ void phase2c(const Params& P, int l, LAS unsigned char* lds) {
    int tid_ = threadIdx.x; asm volatile("" : "+v"(tid_));
    const int tid = tid_;
    LAS float* carryL = (LAS float*)lds;
    const bf16_t* z = (const bf16_t*)(P.ws + WS_Z);
    const float* hlb = (const float*)(P.ws + WS_HL); const float* ppb = (const float*)(P.ws + WS_PP); const float* summ = (const float*)(P.ws + WS_SUM);
    bf16_t* ymix = (bf16_t*)(P.ws + WS_YMIX);
    for (int tile2 = blockIdx.x; tile2 < 2 * N_LRU_TILES; tile2 += gridDim.x) {
        const bool is_sc = tile2 >= N_LRU_TILES; const int tile = is_sc ? tile2 - N_LRU_TILES : tile2;
        const bool smp = tile >= 1024;
        int b = 0, hd, c;
        if (!smp) { hd = tile & 7; c = (tile >> 3) & 31; b = tile >> 8; } else { const int s = tile - 1024; hd = s & 7; c = s >> 3; }
        const int row0 = smp ? NPR + c * 64 : b * SEQ + c * 64;
        const int g = tid & 15, chl = g * 8, ch0 = hd * 128 + chl;
        if (!is_sc) {
            if (tid < 128) { float carry = 0.f; if (!smp) { const int chg = hd * 128 + tid; for (int j = 0; j < c; ++j) { const float* so = summ + ((size_t)(b * 32 + j) * DL + chg) * 2; carry = so[0] * carry + so[1]; } } carryL[tid] = carry; }
            __syncthreads();
            const f32x4 c0 = *(const LAS f32x4*)(carryL + chl), c1 = *(const LAS f32x4*)(carryL + chl + 4);
            const f32x4 gn0 = *(const f32x4*)(P.in[16] + l * DL + ch0), gn1 = *(const f32x4*)(P.in[16] + l * DL + ch0 + 4);
#pragma unroll
            for (int it = 0; it < 2; ++it) {
                const int r = (tid >> 4) + it * 32; const size_t o = (size_t)(row0 + r) * DL + ch0;
                const f32x4 h0 = *(const f32x4*)(hlb + o) + *(const f32x4*)(ppb + o) * c0, h1 = *(const f32x4*)(hlb + o + 4) + *(const f32x4*)(ppb + o + 4) * c1;
                const u32x4 gw = *(const u32x4*)(z + (size_t)(row0 + r) * NIN + DL + ch0); f32x4 g0, g1; UNPACK8(gw, g0, g1);
                f32x4 y0, y1; float ss = 0.f;
#pragma unroll
                for (int j = 0; j < 4; ++j) { y0[j] = h0[j] * g0[j] * sigmoidf_(g0[j]); y1[j] = h1[j] * g1[j] * sigmoidf_(g1[j]); ss += y0[j] * y0[j] + y1[j] * y1[j]; }
                ss += __shfl_xor(ss, 1); ss += __shfl_xor(ss, 2); ss += __shfl_xor(ss, 4); ss += __shfl_xor(ss, 8);
                const float sc = rsqrtf(ss * (1.0f / 128.0f) + 1e-6f);
                *(u32x4*)(ymix + (size_t)(row0 + r) * DM + ch0) = pack8(y0 * sc * gn0, y1 * sc * gn1);
                if (!smp && c == 31 && r == 63) { float* oh = P.out + O_LH_P + (size_t)(l * NB + b) * DL + ch0; *(f32x4*)oh = h0; *(f32x4*)(oh + 4) = h1; }
            }
            __syncthreads();
        } else {
            const float* sw = P.in[15] + (size_t)l * 3 * DL;
            f32x4 w[3][2];
#pragma unroll
            for (int k = 0; k < 3; ++k) { w[k][0] = *(const f32x4*)(sw + k * DL + ch0); w[k][1] = *(const f32x4*)(sw + k * DL + ch0 + 4); }
            const f32x4 gn0 = *(const f32x4*)(P.in[17] + l * DL + ch0), gn1 = *(const f32x4*)(P.in[17] + l * DL + ch0 + 4);
#pragma unroll
            for (int it = 0; it < 2; ++it) {
                const int r = (tid >> 4) + it * 32;
                f32x4 v0 = (f32x4){0.f, 0.f, 0.f, 0.f}, v1 = v0;
#pragma unroll
                for (int k = 0; k < 3; ++k) {
                    f32x4 q0, q1; bool have = true, fromz = true; int tt;
                    if (!smp) { tt = c * 64 + r - k; have = tt >= 0; } else { tt = (r & 3) - k; fromz = tt >= 0; }
                    if (!have) { q0 = (f32x4){0.f, 0.f, 0.f, 0.f}; q1 = q0; }
                    else if (fromz) { const bf16_t* zr = z + (size_t)(row0 + r - k) * NIN + ch0; const u32x4 cv = *(const u32x4*)(zr + 3 * DL), hv = *(const u32x4*)(zr + 4 * DL);
                        f32x4 cc0, cc1, hh0, hh1; UNPACK8(cv, cc0, cc1); UNPACK8(hv, hh0, hh1); q0 = cc0 * hh0; q1 = cc1 * hh1; }
                    else { const int sq = c * 16 + (r >> 2); const float* sp = P.in[4] + ((size_t)(l * DB + sq) * 2 + (2 + tt)) * DL + ch0; q0 = *(const f32x4*)sp; q1 = *(const f32x4*)(sp + 4); }
                    v0 += w[2 - k][0] * q0; v1 += w[2 - k][1] * q1;
                    if (k == 0) {
                        if (!smp) { if (c == 31 && r >= 62) { float* o = P.out + O_SC_P + ((size_t)(l * NB + b) * 2 + (r - 62)) * DL + ch0; *(f32x4*)o = q0; *(f32x4*)(o + 4) = q1; } }
                        else if ((r & 3) >= 2) { const int sq = c * 16 + (r >> 2); float* o = P.out + O_SC_S + ((size_t)(l * DB + sq) * 2 + ((r & 3) - 2)) * DL + ch0; *(f32x4*)o = q0; *(f32x4*)(o + 4) = q1; }
                    }
                }
                const bf16_t* zr = z + (size_t)(row0 + r) * NIN + ch0;
                const u32x4 bw = *(const u32x4*)(zr + 2 * DL), gw = *(const u32x4*)(zr + 5 * DL);
                f32x4 b0, b1, g0, g1; UNPACK8(bw, b0, b1); UNPACK8(gw, g0, g1);
                f32x4 y0, y1; float ss = 0.f;
#pragma unroll
                for (int j = 0; j < 4; ++j) { y0[j] = b0[j] * v0[j] * g0[j] * sigmoidf_(g0[j]); y1[j] = b1[j] * v1[j] * g1[j] * sigmoidf_(g1[j]); ss += y0[j] * y0[j] + y1[j] * y1[j]; }
                ss += __shfl_xor(ss, 1); ss += __shfl_xor(ss, 2); ss += __shfl_xor(ss, 4); ss += __shfl_xor(ss, 8);
                const float sc = rsqrtf(ss * (1.0f / 128.0f) + 1e-6f);
                *(u32x4*)(ymix + (size_t)(row0 + r) * DM + DL + ch0) = pack8(y0 * sc * gn0, y1 * sc * gn1);
            }
        }
    }
}

__device__ void phase4(const Params& P, int l) {
    int tid_ = threadIdx.x; asm volatile("" : "+v"(tid_));
    const int lane = tid_ & 63, wv = (blockIdx.x * 512 + tid_) >> 6, nwv = gridDim.x * 8;
    const float* lg = P.in[22] + l * DM; const float* lb = P.in[23] + l * DM;
    bf16_t* xb = (bf16_t*)(P.ws + WS_XB);
    for (int row = wv; row < MT; row += nwv) {
        float* rp = P.out + (size_t)row * DM;
        f32x4 v[8]; float s = 0.f;
#pragma unroll
        for (int i = 0; i < 8; ++i) { v[i] = *(const f32x4*)(rp + i * 256 + lane * 4); s += (v[i][0] + v[i][1]) + (v[i][2] + v[i][3]); }
#pragma unroll
        for (int o = 32; o >= 1; o >>= 1) s += __shfl_xor(s, o);
        const float mean = s * (1.0f / DM); float q = 0.f;
#pragma unroll
        for (int i = 0; i < 8; ++i) { v[i] = v[i] - mean; q += (v[i][0] * v[i][0] + v[i][1] * v[i][1]) + (v[i][2] * v[i][2] + v[i][3] * v[i][3]); }
#pragma unroll
        for (int o = 32; o >= 1; o >>= 1) q += __shfl_xor(q, o);
        const float rstd = rsqrtf(q * (1.0f / DM) + 1e-5f);
#pragma unroll
        for (int i = 0; i < 8; ++i) { const int col = i * 256 + lane * 4;
            const f32x4 y = v[i] * rstd * *(const f32x4*)(lg + col) + *(const f32x4*)(lb + col);
            *(f32x4*)(rp + col) = y;
            if (l + 1 < NLAYER) { u32x2 w; w.x = cvt_pk_bf16(y[0], y[1]); w.y = cvt_pk_bf16(y[2], y[3]); *(u32x2*)(xb + (size_t)row * DM + col) = w; } }
    }
}

__global__ void __launch_bounds__(512, 2) mega_fwd(Params P) {
    extern __shared__ __attribute__((aligned(16))) unsigned char lds_raw[];
    LAS unsigned char* lds = (LAS unsigned char*)lds_raw;
    cg::grid_group grid = cg::this_grid();
    unsigned char* ws = P.ws;
    int ph = 0;
#define RUN(k) ((k) >= P.ph_lo && (k) < P.ph_hi)
#define SEAM(k) do { if ((k) + 1 < P.ph_hi) grid.sync(); } while (0)
    if (RUN(ph)) { phase0(P, lds); SEAM(ph); } ++ph;
#pragma unroll 1
    for (int l = 0; l < NLAYER; ++l) {
        if (RUN(ph)) {
            { pg8::Gemm g{(const bf16_t*)(ws + WS_XB), (const bf16_t*)(ws + WS_WIN) + (size_t)l * NIN * DM, MT, NIN, DM};
              pg8::StaticOrder S; S.init(MT, NIN, gridDim.x, blockIdx.x);
              pg8::EpiBf16 E{(bf16_t*)(ws + WS_Z), NIN};
              pg8::gemm_phase(lds, g, S, E); }
            { pg8::Gemm g{(const bf16_t*)(ws + WS_PB) + (size_t)l * MT * DPLE, (const bf16_t*)(ws + WS_WP) + (size_t)l * DM * DPLE, MT, DM, DPLE};
              const int skip = (34 * 24) % (int)gridDim.x;
              pg8::StaticOrder S; S.init(MT, DM, (int)gridDim.x - skip, (int)blockIdx.x - skip);
              pg8::EpiBf16 E{(bf16_t*)(ws + WS_E), DM};
              pg8::gemm_phase(lds, g, S, E); }
            SEAM(ph);
        } ++ph;
        if (RUN(ph)) { phase2a(P, l, lds); SEAM(ph); } ++ph;
        if (RUN(ph)) { phase2c(P, l, lds); SEAM(ph); } ++ph;
        if (RUN(ph)) {
            pg8::Gemm g{(const bf16_t*)(ws + WS_YMIX), (const bf16_t*)(ws + WS_WOUT) + (size_t)l * DM * DM, MT, DM, DM};
            pg8::StaticOrder S; S.init(MT, DM, gridDim.x, blockIdx.x);
            pg8::EpiRes E{l == 0 ? P.in[0] : P.out, l == 0 ? P.in[1] : P.out + (size_t)NPR * DM, P.out, (bf16_t*)(ws + WS_RB)};
            pg8::gemm_phase(lds, g, S, E);
            SEAM(ph);
        } ++ph;
        if (RUN(ph)) {
            pg8::Gemm g{(const bf16_t*)(ws + WS_RB), (const bf16_t*)(ws + WS_WG) + (size_t)l * DM * DM, MT, DM, DM};
            pg8::StaticOrder S; S.init(MT, DM, gridDim.x, blockIdx.x);
            pg8::EpiGate E{P.out, (const bf16_t*)(ws + WS_E), P.in[21] + l * DM};
            pg8::gemm_phase(lds, g, S, E);
            SEAM(ph);
        } ++ph;
        if (RUN(ph)) { phase4(P, l); SEAM(ph); } ++ph;
    }
}
constexpr int N_PHASES = 1 + 6 * NLAYER;
constexpr int LDS_BYTES = 131072;

extern "C" void kernel_launch(void* const* d_in, const int* in_sizes, int n_in, void* d_out, int out_size, void* d_ws, size_t ws_size, hipStream_t stream) {
    static int grid = 0;
    if (grid == 0) {
        if (n_in != 24 || ws_size < WS_END) { fprintf(stderr, "kernel_launch: need 24 inputs and >= %zu bytes of workspace (got %d, %zu)\n", (size_t)WS_END, n_in, ws_size); grid = -1; return; }
        int dev = 0, cus = 0, per_cu = 0;
        hipGetDevice(&dev); hipDeviceGetAttribute(&cus, hipDeviceAttributeMultiprocessorCount, dev);
        if (hipFuncSetAttribute((const void*)mega_fwd, hipFuncAttributeMaxDynamicSharedMemorySize, LDS_BYTES) != hipSuccess) { fprintf(stderr, "kernel_launch: hipFuncSetAttribute failed\n"); grid = -1; return; }
        if (hipOccupancyMaxActiveBlocksPerMultiprocessor(&per_cu, (const void*)mega_fwd, 512, LDS_BYTES) != hipSuccess || per_cu < 1) { fprintf(stderr, "kernel_launch: occupancy query failed (%d)\n", per_cu); grid = -1; return; }
        grid = cus * per_cu;
        fprintf(stderr, "kernel_launch: grid %d (%d CUs x %d)\n", grid, cus, per_cu);
    }
    if (grid < 0) return;
    Params p{};
    for (int i = 0; i < 24; ++i) p.in[i] = (const float*)d_in[i];
    p.out = (float*)d_out; p.ws = (unsigned char*)d_ws; p.ph_lo = 0; p.ph_hi = N_PHASES;
    void* args[] = {&p};
    hipError_t e = hipLaunchCooperativeKernel((const void*)mega_fwd, dim3(grid), dim3(512), args, LDS_BYTES, stream);
    if (e != hipSuccess) fprintf(stderr, "kernel_launch: cooperative launch failed: %s (grid %d)\n", hipGetErrorString(e), grid);
}
```

```cpp
#include <hip/hip_runtime.h>
#include <hip/hip_cooperative_groups.h>
#include <cstdio>
namespace cg = cooperative_groups;

#define LAS __attribute__((address_space(3)))
typedef unsigned short bf16_t;
typedef short bf16x8 __attribute__((ext_vector_type(8)));
typedef float f32x4 __attribute__((ext_vector_type(4)));
typedef unsigned u32x4 __attribute__((ext_vector_type(4)));
typedef unsigned u32x2 __attribute__((ext_vector_type(2)));

constexpr int DM = 2048, NPR = 8192, NSR = 512, MT = 8704, NLAYER = 2, DL = 1024, NIN = 6144, DPLE = 256, SEQ = 2048, NB = 4, DB = 128;
constexpr float ALPHA = 1.4142135623730951f;
constexpr size_t O_Y = 0, O_LH_P = (size_t)MT * DM, O_LC_P = O_LH_P + 2 * 4 * 1024, O_SC_P = O_LC_P + 2 * 4 * 3 * 1024,
                 O_LH_S = O_SC_P + 2 * 4 * 2 * 1024, O_LC_S = O_LH_S + 2 * 128 * 1024, O_SC_S = O_LC_S + 2 * 128 * 3 * 1024;
constexpr size_t SZ_ACT = (size_t)MT * DM * 2;
constexpr size_t WS_XB = 0, WS_PB = WS_XB + SZ_ACT, WS_WIN = WS_PB + (size_t)2 * MT * 256 * 2, WS_WOUT = WS_WIN + (size_t)2 * NIN * DM * 2,
                 WS_WG = WS_WOUT + (size_t)2 * DM * DM * 2, WS_WP = WS_WG + (size_t)2 * DM * DM * 2, WS_WA = WS_WP + (size_t)2 * DM * 256 * 2,
                 WS_WX = WS_WA + 524288, WS_SUM = WS_WX + 524288, WS_Z = WS_SUM + 1048576, WS_HL = WS_Z + (size_t)MT * NIN * 2,
                 WS_PP = WS_HL + SZ_ACT, WS_YMIX = WS_PP + SZ_ACT, WS_E = WS_YMIX + SZ_ACT, WS_BAR = WS_E + SZ_ACT, WS_END = WS_BAR + 16384;
constexpr size_t WS_RB = WS_HL;

struct Params { const float* in[24]; float* out; unsigned char* ws; int ph_lo, ph_hi; };

__device__ __forceinline__ unsigned cvt_pk_bf16(float lo, float hi) { unsigned r; asm volatile("v_cvt_pk_bf16_f32 %0, %1, %2" : "=v"(r) : "v"(lo), "v"(hi)); return r; }
__device__ __forceinline__ float bf_lo(unsigned w) { return __uint_as_float(w << 16); }
__device__ __forceinline__ float bf_hi(unsigned w) { return __uint_as_float(w & 0xffff0000u); }
__device__ __forceinline__ float sigmoidf_(float x) { return 1.0f / (1.0f + __expf(-x)); }
__device__ __forceinline__ u32x4 pack8(const f32x4 a, const f32x4 b) { u32x4 w; w.x = cvt_pk_bf16(a[0], a[1]); w.y = cvt_pk_bf16(a[2], a[3]); w.z = cvt_pk_bf16(b[0], b[1]); w.w = cvt_pk_bf16(b[2], b[3]); return w; }
__device__ __forceinline__ void unpack8_(const u32x4 q, f32x4& lo, f32x4& hi) { lo = (f32x4){bf_lo(q[0]), bf_hi(q[0]), bf_lo(q[1]), bf_hi(q[1])}; hi = (f32x4){bf_lo(q[2]), bf_hi(q[2]), bf_lo(q[3]), bf_hi(q[3])}; }
#define UNPACK8(q_, lo_, hi_) unpack8_(q_, lo_, hi_)

namespace pg8 {
constexpr int BM = 256, BK = 64, HALF = 128, HTB = HALF * BK * 2, STAGE_BYTES = 8 * HTB, NXCD = 8, WGM = 8;
__host__ __device__ __forceinline__ int lds_byte(int r, int c) { const int st = (r >> 4) * 2 + (c >> 5), rr = r & 15, cc = c & 31, ob = rr * 64 + cc * 2; return st * 1024 + (ob ^ (((ob >> 9) & 1) << 5)); }
__host__ __device__ __forceinline__ void stage_rc(int b, int& R, int& C) { const int st = b / 1024, sb = b % 1024, swz = sb ^ (((sb >> 9) & 1) << 5); R = (st >> 1) * 16 + swz / 64; C = (st & 1) * 32 + (swz % 64) / 2; }
__host__ __device__ __forceinline__ int perm32(int rho) { const int n = rho >> 4, i = rho & 15; return 8 * (i >> 2) + 4 * n + (i & 3); }
struct Unit { int pm, pn; };
struct Gemm { const bf16_t* A; const bf16_t* Bt; int M, N, K; };
struct StaticOrder {
    int nM, nN, nwg, G, c;
    __device__ void init(int M, int N, int G_, int c_) { nM = M / BM; nN = N / BM; nwg = nM * nN; G = G_; c = c_; }
    __device__ bool next(int i, Unit& u) const {
        const long L = (long)i * G + c; if (L >= nwg || c < 0) return false;
        int wgid = (int)L; { const int q = nwg / NXCD, r = nwg % NXCD, xcd = wgid % NXCD, off = wgid / NXCD; wgid = (xcd < r ? xcd * (q + 1) : r * (q + 1) + (xcd - r) * q) + off; }
        const int nig = WGM * nN, gid = wgid / nig, fm = gid * WGM, gsz = (nM - fm) < WGM ? (nM - fm) : WGM;
        u.pm = fm + ((wgid % nig) % gsz); u.pn = (wgid % nig) / gsz; return true;
    }
};
struct EpiBf16 {
    bf16_t* O; int ldc;
    __device__ __forceinline__ void operator()(const f32x4 (&acc)[2][2][4][2], const Unit& u, int wr, int wc, int fr, int fq) const {
        const int row0 = u.pm * BM + wr * 64 + fr, col0 = u.pn * BM + wc * 32 + 8 * fq;
#pragma unroll
        for (int ai = 0; ai < 2; ++ai)
#pragma unroll
            for (int m = 0; m < 4; ++m) { bf16_t* rowp = O + (size_t)(row0 + ai * HALF + m * 16) * ldc + col0;
#pragma unroll
                for (int bj = 0; bj < 2; ++bj) *(u32x4*)(rowp + bj * HALF) = pack8(acc[ai][bj][m][0], acc[ai][bj][m][1]); }
    }
};
struct EpiRes {
    const float* xp; const float* xs; float* r32; bf16_t* rb;
    __device__ __forceinline__ void operator()(const f32x4 (&acc)[2][2][4][2], const Unit& u, int wr, int wc, int fr, int fq) const {
        const int row0 = u.pm * BM + wr * 64 + fr, col0 = u.pn * BM + wc * 32 + 8 * fq;
        const float* xbase = (u.pm * BM < NPR) ? xp : xs - (size_t)NPR * DM;
#pragma unroll
        for (int ai = 0; ai < 2; ++ai)
#pragma unroll
            for (int m = 0; m < 4; ++m) { const size_t off = (size_t)(row0 + ai * HALF + m * 16) * DM + col0;
#pragma unroll
                for (int bj = 0; bj < 2; ++bj) {
                    const f32x4 x0 = *(const f32x4*)(xbase + off + bj * HALF), x1 = *(const f32x4*)(xbase + off + bj * HALF + 4);
                    const f32x4 v0 = acc[ai][bj][m][0] + ALPHA * x0, v1 = acc[ai][bj][m][1] + ALPHA * x1;
                    *(f32x4*)(r32 + off + bj * HALF) = v0; *(f32x4*)(r32 + off + bj * HALF + 4) = v1;
                    *(u32x4*)(rb + off + bj * HALF) = pack8(v0, v1); }
                asm volatile("" ::: "memory"); }
    }
};
struct EpiGate {
    float* r32; const bf16_t* e; const float* bg;
    __device__ __forceinline__ void operator()(const f32x4 (&acc)[2][2][4][2], const Unit& u, int wr, int wc, int fr, int fq) const {
        const int row0 = u.pm * BM + wr * 64 + fr, col0 = u.pn * BM + wc * 32 + 8 * fq;
        f32x4 bv[2][2];
#pragma unroll
        for (int bj = 0; bj < 2; ++bj)
#pragma unroll
            for (int n = 0; n < 2; ++n) bv[bj][n] = *(const f32x4*)(bg + col0 + bj * HALF + 4 * n);
#pragma unroll
        for (int ai = 0; ai < 2; ++ai)
#pragma unroll
            for (int m = 0; m < 4; ++m) { const size_t off = (size_t)(row0 + ai * HALF + m * 16) * DM + col0;
#pragma unroll
                for (int bj = 0; bj < 2; ++bj) {
                    const f32x4 r0 = *(const f32x4*)(r32 + off + bj * HALF), r1 = *(const f32x4*)(r32 + off + bj * HALF + 4);
                    const u32x4 ew = *(const u32x4*)(e + off + bj * HALF); f32x4 e0, e1; UNPACK8(ew, e0, e1);
                    f32x4 g0 = acc[ai][bj][m][0] + bv[bj][0], g1 = acc[ai][bj][m][1] + bv[bj][1];
#pragma unroll
                    for (int j = 0; j < 4; ++j) { g0[j] = sigmoidf_(g0[j]); g1[j] = sigmoidf_(g1[j]); }
                    *(f32x4*)(r32 + off + bj * HALF) = r0 + g0 * e0; *(f32x4*)(r32 + off + bj * HALF + 4) = r1 + g1 * e1; }
                asm volatile("" ::: "memory"); }
    }
};

template <class Epi, class Sched>
__device__ __forceinline__ void gemm_phase(LAS unsigned char* lds, const Gemm g, const Sched& S, const Epi& E) {
    int tid_ = threadIdx.x; asm volatile("" : "+v"(tid_));
    const int tid = tid_, wid = __builtin_amdgcn_readfirstlane(tid >> 6), lane = tid & 63, wr = wid >> 2, wc = wid & 3, fr = lane & 15, fq = lane >> 4;
    const int K = g.K, nt = K / BK;
    unsigned voffA[2], voffB[2];
#pragma unroll
    for (int i = 0; i < 2; ++i) { int R, C; stage_rc(tid * 16 + i * 8192, R, C); const int Rb = (R & ~31) + perm32(R & 31);
        voffA[i] = (unsigned)(R * K + C) * 2u; voffB[i] = (unsigned)(Rb * K + C) * 2u; }
    const size_t kstep = (size_t)(BK * 2);
    const size_t hstep = (size_t)HALF * K * 2;
    const size_t tstep = 2 * hstep;
    const unsigned ldsw = (unsigned)wid * 1024u;
    const int aoff = lds_byte(wr * 64 + fr, fq * 8), boff = lds_byte(wc * 32 + fr, fq * 8);
#define PG8_SA(b, h) (((b) * 2 + (h)) * HTB)
#define PG8_SB(b, h) ((4 + (b) * 2 + (h)) * HTB)
#define PG8_STAGE(bufoff, gbase, voff) do { _Pragma("unroll") for (int _i = 0; _i < 2; ++_i) \
        __builtin_amdgcn_global_load_lds((const unsigned*)((const char*)(gbase) + (voff)[_i]), (LAS unsigned*)(lds + (bufoff) + ldsw + _i * 8192), 16, 0, 0); } while (0)
#define PG8_LDA(dst, b, h) do { _Pragma("unroll") for (int m = 0; m < 4; ++m) _Pragma("unroll") for (int k = 0; k < 2; ++k) dst[m][k] = *(const LAS bf16x8*)(lds + PG8_SA(b, h) + aoff + m * 2048 + k * 1024); } while (0)
#define PG8_LDB(dst, b, h) do { _Pragma("unroll") for (int n = 0; n < 2; ++n) _Pragma("unroll") for (int k = 0; k < 2; ++k) dst[n][k] = *(const LAS bf16x8*)(lds + PG8_SB(b, h) + boff + n * 2048 + k * 1024); } while (0)
#define PG8_MMA(ai, bj, At, Bt) do { __builtin_amdgcn_s_setprio(1); _Pragma("unroll") for (int m = 0; m < 4; ++m) _Pragma("unroll") for (int n = 0; n < 2; ++n) _Pragma("unroll") for (int k = 0; k < 2; ++k) \
        acc[ai][bj][m][n] = __builtin_amdgcn_mfma_f32_16x16x32_bf16(Bt[n][k], At[m][k], acc[ai][bj][m][n], 0, 0, 0); __builtin_amdgcn_s_setprio(0); } while (0)
#define PG8_WAIT_V(n) asm volatile("s_waitcnt vmcnt(" #n ")" ::: "memory")
#define PG8_WAIT_L(n) asm volatile("s_waitcnt lgkmcnt(" #n ")" ::: "memory")
#define PG8_BAR __builtin_amdgcn_s_barrier()
#define PG8_SCHED __builtin_amdgcn_sched_barrier(0)
    Unit cur, nxt; int ui = 0;
    if (!S.next(0, cur)) return;
    f32x4 acc[2][2][4][2];
#pragma unroll
    for (int a = 0; a < 2; ++a)
#pragma unroll
        for (int b = 0; b < 2; ++b)
#pragma unroll
            for (int m = 0; m < 4; ++m)
#pragma unroll
                for (int n = 0; n < 2; ++n) acc[a][b][m][n] = (f32x4){0.f, 0.f, 0.f, 0.f};
    bf16x8 At[4][2], B0[2][2], B1[2][2];
    const char* cA = (const char*)g.A + (size_t)cur.pm * tstep; const char* cB = (const char*)g.Bt + (size_t)cur.pn * tstep;
    PG8_STAGE(PG8_SB(0, 0), cB, voffB); PG8_STAGE(PG8_SA(0, 0), cA, voffA); PG8_STAGE(PG8_SB(0, 1), cB + hstep, voffB); PG8_STAGE(PG8_SA(0, 1), cA + hstep, voffA);
    if (wr == 1) PG8_BAR;
    PG8_WAIT_V(4); PG8_BAR;
    PG8_STAGE(PG8_SB(1, 0), cB + kstep, voffB); PG8_STAGE(PG8_SA(1, 0), cA + kstep, voffA); PG8_STAGE(PG8_SB(1, 1), cB + hstep + kstep, voffB);
    PG8_WAIT_V(6); PG8_BAR;
    for (;;) {
        const bool has_next = S.next(ui + 1, nxt);
        const char* nA = has_next ? (const char*)g.A + (size_t)nxt.pm * tstep : cA; const char* nB = has_next ? (const char*)g.Bt + (size_t)nxt.pn * tstep : cB;
        for (int t = 0; t < nt; t += 2) {
            const bool last = (t == nt - 2);
            const char* a1 = cA + (size_t)(t + 1) * kstep;
            const char* a2 = last ? nA : cA + (size_t)(t + 2) * kstep; const char* b2 = last ? nB : cB + (size_t)(t + 2) * kstep;
            const char* a3 = a2 + kstep; const char* b3 = b2 + kstep;
            PG8_LDB(B0, 0, 0); PG8_SCHED; PG8_LDA(At, 0, 0); PG8_STAGE(PG8_SA(1, 1), a1 + hstep, voffA);
            PG8_WAIT_L(8); PG8_BAR; PG8_WAIT_L(0); PG8_MMA(0, 0, At, B0); PG8_BAR; PG8_SCHED;
            PG8_LDB(B1, 0, 1); PG8_STAGE(PG8_SB(0, 0), b2, voffB);
            PG8_BAR; PG8_WAIT_L(0); PG8_MMA(0, 1, At, B1); PG8_BAR;
            PG8_LDA(At, 0, 1); PG8_STAGE(PG8_SA(0, 0), a2, voffA);
            PG8_BAR; PG8_WAIT_L(0); PG8_MMA(1, 0, At, B0); PG8_BAR; PG8_SCHED;
            PG8_STAGE(PG8_SB(0, 1), b2 + hstep, voffB);
            PG8_WAIT_V(6); PG8_BAR; PG8_MMA(1, 1, At, B1); PG8_BAR;
            PG8_LDB(B0, 1, 0); PG8_SCHED; PG8_LDA(At, 1, 0); PG8_STAGE(PG8_SA(0, 1), a2 + hstep, voffA);
            PG8_WAIT_L(8); PG8_BAR; PG8_WAIT_L(0); PG8_MMA(0, 0, At, B0); PG8_BAR; PG8_SCHED;
            PG8_LDB(B1, 1, 1); PG8_STAGE(PG8_SB(1, 0), b3, voffB);
            PG8_BAR; PG8_WAIT_L(0); PG8_MMA(0, 1, At, B1); PG8_BAR;
            PG8_LDA(At, 1, 1); PG8_STAGE(PG8_SA(1, 0), a3, voffA);
            PG8_BAR; PG8_WAIT_L(0); PG8_MMA(1, 0, At, B0); PG8_BAR; PG8_SCHED;
            PG8_STAGE(PG8_SB(1, 1), b3 + hstep, voffB);
            PG8_WAIT_V(6); PG8_BAR; PG8_MMA(1, 1, At, B1); PG8_BAR;
        }
        E(acc, cur, wr, wc, fr, fq);
        if (!has_next) break;
#pragma unroll
        for (int a = 0; a < 2; ++a)
#pragma unroll
            for (int b = 0; b < 2; ++b)
#pragma unroll
                for (int m = 0; m < 4; ++m)
#pragma unroll
                    for (int n = 0; n < 2; ++n) acc[a][b][m][n] = (f32x4){0.f, 0.f, 0.f, 0.f};
        cur = nxt; cA = nA; cB = nB; ++ui;
    }
    PG8_WAIT_V(0);
    if (wr == 0) PG8_BAR;
    PG8_BAR;
#undef PG8_SA
#undef PG8_SB
#undef PG8_STAGE
#undef PG8_LDA
#undef PG8_LDB
#undef PG8_MMA
#undef PG8_WAIT_V
#undef PG8_WAIT_L
#undef PG8_BAR
#undef PG8_SCHED
}
}

__device__ __forceinline__ void cvt_rows(const float* __restrict__ srcA, size_t nA8, const float* __restrict__ srcB, size_t nB8, bf16_t* __restrict__ dst) {
    const size_t n8 = nA8 + nB8;
    for (size_t i = (size_t)blockIdx.x * 512 + threadIdx.x; i < n8; i += (size_t)gridDim.x * 512) {
        const float* s = (i < nA8) ? srcA + i * 8 : srcB + (i - nA8) * 8;
        const f32x4 a = *(const f32x4*)s, b = *(const f32x4*)(s + 4);
        *(u32x4*)(dst + i * 8) = pack8(a, b);
    }
}
__device__ __forceinline__ void tr_tile(const float* __restrict__ src, bf16_t* __restrict__ dst, int R, int C, int idx, LAS float* tile) {
    int tid_ = threadIdx.x; asm volatile("" : "+v"(tid_));
    const int tid = tid_, ntc = C >> 6, tr = idx / ntc, tc = idx - tr * ntc;
#pragma unroll
    for (int i = 0; i < 2; ++i) { const int e = tid + 512 * i, row = e >> 4, c4 = e & 15;
        const f32x4 v = *(const f32x4*)(src + (size_t)(tr * 64 + row) * C + tc * 64 + c4 * 4);
#pragma unroll
        for (int j = 0; j < 4; ++j) tile[row * 65 + c4 * 4 + j] = v[j]; }
    __syncthreads();
    { const int cc = tid >> 3, r0 = (tid & 7) * 8; f32x4 a, b;
#pragma unroll
      for (int j = 0; j < 4; ++j) { a[j] = tile[(r0 + j) * 65 + cc]; b[j] = tile[(r0 + 4 + j) * 65 + cc]; }
      *(u32x4*)(dst + (size_t)(tc * 64 + cc) * R + tr * 64 + r0) = pack8(a, b); }
    __syncthreads();
}
__device__ void phase0(const Params& P, LAS unsigned char* lds) {
    unsigned char* ws = P.ws;
    cvt_rows(P.in[0], (size_t)NPR * DM / 8, P.in[1], (size_t)NSR * DM / 8, (bf16_t*)(ws + WS_XB));
    for (int l = 0; l < NLAYER; ++l)
        cvt_rows(P.in[5] + (size_t)l * NPR * DPLE, (size_t)NPR * DPLE / 8, P.in[6] + (size_t)l * NSR * DPLE, (size_t)NSR * DPLE / 8, (bf16_t*)(ws + WS_PB) + (size_t)l * MT * DPLE);
    LAS float* tile = (LAS float*)lds;
    constexpr int T_IN = 32 * 96, T_SQ = 32 * 32, T_WP = 4 * 32, T_HD = 4;
    constexpr int E0 = 2 * T_IN, E1 = E0 + 2 * T_SQ, E2 = E1 + 2 * T_SQ, E3 = E2 + 2 * T_WP, E4 = E3 + 16 * T_HD, E5 = E4 + 16 * T_HD;
    for (int T = blockIdx.x; T < E5; T += gridDim.x) {
        if (T < E0) { const int l = T / T_IN, i = T - l * T_IN; tr_tile(P.in[7] + (size_t)l * DM * NIN, (bf16_t*)(ws + WS_WIN) + (size_t)l * NIN * DM, DM, NIN, i, tile); }
        else if (T < E1) { const int t = T - E0, l = t / T_SQ, i = t - l * T_SQ; tr_tile(P.in[18] + (size_t)l * DM * DM, (bf16_t*)(ws + WS_WOUT) + (size_t)l * DM * DM, DM, DM, i, tile); }
        else if (T < E2) { const int t = T - E1, l = t / T_SQ, i = t - l * T_SQ; tr_tile(P.in[20] + (size_t)l * DM * DM, (bf16_t*)(ws + WS_WG) + (size_t)l * DM * DM, DM, DM, i, tile); }
        else if (T < E3) { const int t = T - E2, l = t / T_WP, i = t - l * T_WP; tr_tile(P.in[19] + (size_t)l * DPLE * DM, (bf16_t*)(ws + WS_WP) + (size_t)l * DM * DPLE, DPLE, DM, i, tile); }
        else if (T < E4) { const int t = T - E3, mtx = t >> 2, i = t & 3; tr_tile(P.in[10] + (size_t)mtx * 16384, (bf16_t*)(ws + WS_WA) + (size_t)mtx * 16384, 128, 128, i, tile); }
        else { const int t = T - E4, mtx = t >> 2, i = t & 3; tr_tile(P.in[12] + (size_t)mtx * 16384, (bf16_t*)(ws + WS_WX) + (size_t)mtx * 16384, 128, 128, i, tile); }
    }
}

constexpr int N_LRU_TILES = 4 * 32 * 8 + 8 * 8;
__device__ void phase2a(const Params& P, int l, LAS unsigned char* lds) {
    int tid_ = threadIdx.x; asm volatile("" : "+v"(tid_));
    const int tid = tid_, lane = tid & 63, wid = tid >> 6, fr = lane & 15, fq = lane >> 4;
    LAS bf16_t* xcA = (LAS bf16_t*)lds;
    LAS float* xcF = (LAS float*)(lds + 17408);
    LAS float* aL = (LAS float*)(lds + 17408 + 33792);
    LAS float* uL = aL + 64 * 128;
    LAS float* subA = uL + 64 * 128;
    LAS float* subH = subA + 512;
    const bf16_t* z = (const bf16_t*)(P.ws + WS_Z);
    float* hlb = (float*)(P.ws + WS_HL); float* ppb = (float*)(P.ws + WS_PP); float* summ = (float*)(P.ws + WS_SUM);
    const float* cw = P.in[8] + (size_t)l * 4 * DL; const float* cb = P.in[9] + (size_t)l * DL;
    for (int tile = blockIdx.x; tile < N_LRU_TILES; tile += gridDim.x) {
        const bool smp = tile >= 1024;
        int b = 0, hd, c;
        if (!smp) { hd = tile & 7; c = (tile >> 3) & 31; b = tile >> 8; } else { const int s = tile - 1024; hd = s & 7; c = s >> 3; }
        const int row0 = smp ? NPR + c * 64 : b * SEQ + c * 64;
        {
            const int g = tid & 15, chl = g * 8, ch0 = hd * 128 + chl;
            f32x4 w[4][2], bias[2];
#pragma unroll
            for (int k = 0; k < 4; ++k) { w[k][0] = *(const f32x4*)(cw + k * DL + ch0); w[k][1] = *(const f32x4*)(cw + k * DL + ch0 + 4); }
            bias[0] = *(const f32x4*)(cb + ch0); bias[1] = *(const f32x4*)(cb + ch0 + 4);
#pragma unroll
            for (int it = 0; it < 2; ++it) {
                const int r = (tid >> 4) + it * 32;
                f32x4 a0 = bias[0], a1 = bias[1];
#pragma unroll
                for (int k = 0; k < 4; ++k) {
                    f32x4 x0, x1; bool have = true, fromz = true; int tt;
                    if (!smp) { tt = c * 64 + r - k; have = tt >= 0; } else { tt = (r & 3) - k; fromz = tt >= 0; }
                    if (!have) { x0 = (f32x4){0.f, 0.f, 0.f, 0.f}; x1 = x0; }
                    else if (fromz) { const u32x4 v = *(const u32x4*)(z + (size_t)(row0 + r - k) * NIN + ch0); UNPACK8(v, x0, x1); }
                    else { const int sq = c * 16 + (r >> 2); const float* sp = P.in[3] + ((size_t)(l * DB + sq) * 3 + (3 + tt)) * DL + ch0; x0 = *(const f32x4*)sp; x1 = *(const f32x4*)(sp + 4); }
                    a0 += w[3 - k][0] * x0; a1 += w[3 - k][1] * x1;
                    if (k == 0) {
                        if (!smp) { if (c == 31 && r >= 61) { float* o = P.out + O_LC_P + ((size_t)(l * NB + b) * 3 + (r - 61)) * DL + ch0; *(f32x4*)o = x0; *(f32x4*)(o + 4) = x1; } }
                        else if ((r & 3) >= 1) { const int sq = c * 16 + (r >> 2); float* o = P.out + O_LC_S + ((size_t)(l * DB + sq) * 3 + ((r & 3) - 1)) * DL + ch0; *(f32x4*)o = x0; *(f32x4*)(o + 4) = x1; }
                    }
                }
                *(LAS f32x4*)(xcF + r * 132 + chl) = a0; *(LAS f32x4*)(xcF + r * 132 + chl + 4) = a1;
                *(LAS u32x4*)(xcA + r * 136 + chl) = pack8(a0, a1);
            }
        }
        __syncthreads();
        {
            const int n0 = wid * 16, chl = n0 + fr, chg = hd * 128 + chl;
            const bf16_t* waT = (const bf16_t*)(P.ws + WS_WA) + ((size_t)((l * 8 + hd) * 128 + chl)) * 128 + fq * 8;
            const bf16_t* wxT = (const bf16_t*)(P.ws + WS_WX) + ((size_t)((l * 8 + hd) * 128 + chl)) * 128 + fq * 8;
            bf16x8 fa[4], fx[4];
#pragma unroll
            for (int kk = 0; kk < 4; ++kk) { fa[kk] = *(const bf16x8*)(waT + kk * 32); fx[kk] = *(const bf16x8*)(wxT + kk * 32); }
            f32x4 accR[4], accI[4];
#pragma unroll
            for (int m = 0; m < 4; ++m) { accR[m] = (f32x4){0.f, 0.f, 0.f, 0.f}; accI[m] = accR[m]; }
#pragma unroll
            for (int m = 0; m < 4; ++m)
#pragma unroll
                for (int kk = 0; kk < 4; ++kk) {
                    const bf16x8 a = *(const LAS bf16x8*)(xcA + (m * 16 + fr) * 136 + kk * 32 + fq * 8);
                    accR[m] = __builtin_amdgcn_mfma_f32_16x16x32_bf16(a, fa[kk], accR[m], 0, 0, 0);
                    accI[m] = __builtin_amdgcn_mfma_f32_16x16x32_bf16(a, fx[kk], accI[m], 0, 0, 0);
                }
            const float ba = P.in[11][l * DL + chg], bx = P.in[13][l * DL + chg], lam = P.in[14][l * DL + chg];
            const float sp = log1pf(expf(-lam));
#pragma unroll
            for (int m = 0; m < 4; ++m)
#pragma unroll
                for (int j = 0; j < 4; ++j) {
                    const int row = m * 16 + fq * 4 + j;
                    const float rr = sigmoidf_(accR[m][j] + ba), ii = sigmoidf_(accI[m][j] + bx);
                    const float la = -8.0f * rr * sp, a = expf(la), mult = sqrtf(fmaxf(-expm1f(2.0f * la), 0.0f));
                    aL[row * 128 + chl] = a; uL[row * 128 + chl] = mult * ii * xcF[row * 132 + chl];
                }
        }
        __syncthreads();
        {
            const int ch = tid & 127, sub = tid >> 7, chg = hd * 128 + ch;
            if (!smp) {
                float h = 0.f, pr = 1.f;
#pragma unroll 4
                for (int s = 0; s < 16; ++s) { const int t = sub * 16 + s; const float a = aL[t * 128 + ch], u = uL[t * 128 + ch]; h = a * h + u; pr *= a; uL[t * 128 + ch] = h; aL[t * 128 + ch] = pr; }
                subA[sub * 128 + ch] = pr; subH[sub * 128 + ch] = h;
                __syncthreads();
                float carry = 0.f, pref = 1.f;
                for (int j = 0; j < sub; ++j) { const float A = subA[j * 128 + ch]; carry = A * carry + subH[j * 128 + ch]; pref *= A; }
#pragma unroll 4
                for (int s = 0; s < 16; ++s) { const int t = sub * 16 + s; const size_t o = (size_t)(row0 + t) * DL + chg;
                    hlb[o] = uL[t * 128 + ch] + aL[t * 128 + ch] * carry; ppb[o] = aL[t * 128 + ch] * pref; }
                if (sub == 3) { const float A3 = subA[3 * 128 + ch]; float* so = summ + ((size_t)(b * 32 + c) * DL + chg) * 2; so[0] = pref * A3; so[1] = A3 * carry + subH[3 * 128 + ch]; }
            } else {
#pragma unroll
                for (int q = 0; q < 4; ++q) { const int sl = sub * 4 + q, sq = c * 16 + sl;
                    float h = P.in[2][(size_t)(l * DB + sq) * DL + chg];
#pragma unroll
                    for (int t = 0; t < 4; ++t) { const int r = sl * 4 + t; h = aL[r * 128 + ch] * h + uL[r * 128 + ch]; const size_t o = (size_t)(row0 + r) * DL + chg; hlb[o] = h; ppb[o] = 0.f; }
                    P.out[O_LH_S + (size_t)(l * DB + sq) * DL + chg] = h; }
            }
        }
        __syncthreads();
    }
}

__device__ void phase2c(const Params& P, int l, LAS unsigned char* lds) {
    int tid_ = threadIdx.x; asm volatile("" : "+v"(tid_));
    const int tid = tid_;
    LAS float* carryL = (LAS float*)lds;
    const bf16_t* z = (const bf16_t*)(P.ws + WS_Z);
    const float* hlb = (const float*)(P.ws + WS_HL); const float* ppb = (const float*)(P.ws + WS_PP); const float* summ = (const float*)(P.ws + WS_SUM);
    bf16_t* ymix = (bf16_t*)(P.ws + WS_YMIX);
    for (int tile2 = blockIdx.x; tile2 < 2 * N_LRU_TILES; tile2 += gridDim.x) {
        const bool is_sc = tile2 >= N_LRU_TILES; const int tile = is_sc ? tile2 - N_LRU_TILES : tile2;
        const bool smp = tile >= 1024;
        int b = 0, hd, c;
        if (!smp) { hd = tile & 7; c = (tile >> 3) & 31; b = tile >> 8; } else { const int s = tile - 1024; hd = s & 7; c = s >> 3; }
        const int row0 = smp ? NPR + c * 64 : b * SEQ + c * 64;
        const int g = tid & 15, chl = g * 8, ch0 = hd * 128 + chl;
        if (!is_sc) {
            if (tid < 128) { float carry = 0.f; if (!smp) { const int chg = hd * 128 + tid; for (int j = 0; j < c; ++j) { const float* so = summ + ((size_t)(b * 32 + j) * DL + chg) * 2; carry = so[0] * carry + so[1]; } } carryL[tid] = carry; }
            __syncthreads();
            const f32x4 c0 = *(const LAS f32x4*)(carryL + chl), c1 = *(const LAS f32x4*)(carryL + chl + 4);
            const f32x4 gn0 = *(const f32x4*)(P.in[16] + l * DL + ch0), gn1 = *(const f32x4*)(P.in[16] + l * DL + ch0 + 4);
#pragma unroll
            for (int it = 0; it < 2; ++it) {
                const int r = (tid >> 4) + it * 32; const size_t o = (size_t)(row0 + r) * DL + ch0;
                const f32x4 h0 = *(const f32x4*)(hlb + o) + *(const f32x4*)(ppb + o) * c0, h1 = *(const f32x4*)(hlb + o + 4) + *(const f32x4*)(ppb + o + 4) * c1;
                const u32x4 gw = *(const u32x4*)(z + (size_t)(row0 + r) * NIN + DL + ch0); f32x4 g0, g1; UNPACK8(gw, g0, g1);
                f32x4 y0, y1; float ss = 0.f;
#pragma unroll
                for (int j = 0; j < 4; ++j) { y0[j] = h0[j] * g0[j] * sigmoidf_(g0[j]); y1[j] = h1[j] * g1[j] * sigmoidf_(g1[j]); ss += y0[j] * y0[j] + y1[j] * y1[j]; }
                ss += __shfl_xor(ss, 1); ss += __shfl_xor(ss, 2); ss += __shfl_xor(ss, 4); ss += __shfl_xor(ss, 8);
                const float sc = rsqrtf(ss * (1.0f / 128.0f) + 1e-6f);
                *(u32x4*)(ymix + (size_t)(row0 + r) * DM + ch0) = pack8(y0 * sc * gn0, y1 * sc * gn1);
                if (!smp && c == 31 && r == 63) { float* oh = P.out + O_LH_P + (size_t)(l * NB + b) * DL + ch0; *(f32x4*)oh = h0; *(f32x4*)(oh + 4) = h1; }
            }
            __syncthreads();
        } else {
            const float* sw = P.in[15] + (size_t)l * 3 * DL;
            f32x4 w[3][2];
#pragma unroll
            for (int k = 0; k < 3; ++k) { w[k][0] = *(const f32x4*)(sw + k * DL + ch0); w[k][1] = *(const f32x4*)(sw + k * DL + ch0 + 4); }
            const f32x4 gn0 = *(const f32x4*)(P.in[17] + l * DL + ch0), gn1 = *(const f32x4*)(P.in[17] + l * DL + ch0 + 4);
#pragma unroll
            for (int it = 0; it < 2; ++it) {
                const int r = (tid >> 4) + it * 32;
                f32x4 v0 = (f32x4){0.f, 0.f, 0.f, 0.f}, v1 = v0;
#pragma unroll
                for (int k = 0; k < 3; ++k) {
                    f32x4 q0, q1; bool have = true, fromz = true; int tt;
                    if (!smp) { tt = c * 64 + r - k; have = tt >= 0; } else { tt = (r & 3) - k; fromz = tt >= 0; }
                    if (!have) { q0 = (f32x4){0.f, 0.f, 0.f, 0.f}; q1 = q0; }
                    else if (fromz) { const bf16_t* zr = z + (size_t)(row0 + r - k) * NIN + ch0; const u32x4 cv = *(const u32x4*)(zr + 3 * DL), hv = *(const u32x4*)(zr + 4 * DL);
                        f32x4 cc0, cc1, hh0, hh1; UNPACK8(cv, cc0, cc1); UNPACK8(hv, hh0, hh1); q0 = cc0 * hh0; q1 = cc1 * hh1; }
                    else { const int sq = c * 16 + (r >> 2); const float* sp = P.in[4] + ((size_t)(l * DB + sq) * 2 + (2 + tt)) * DL + ch0; q0 = *(const f32x4*)sp; q1 = *(const f32x4*)(sp + 4); }
                    v0 += w[2 - k][0] * q0; v1 += w[2 - k][1] * q1;
                    if (k == 0) {
                        if (!smp) { if (c == 31 && r >= 62) { float* o = P.out + O_SC_P + ((size_t)(l * NB + b) * 2 + (r - 62)) * DL + ch0; *(f32x4*)o = q0; *(f32x4*)(o + 4) = q1; } }
                        else if ((r & 3) >= 2) { const int sq = c * 16 + (r >> 2); float* o = P.out + O_SC_S + ((size_t)(l * DB + sq) * 2 + ((r & 3) - 2)) * DL + ch0; *(f32x4*)o = q0; *(f32x4*)(o + 4) = q1; }
                    }
                }
                const bf16_t* zr = z + (size_t)(row0 + r) * NIN + ch0;
                const u32x4 bw = *(const u32x4*)(zr + 2 * DL), gw = *(const u32x4*)(zr + 5 * DL);
                f32x4 b0, b1, g0, g1; UNPACK8(bw, b0, b1); UNPACK8(gw, g0, g1);
                f32x4 y0, y1; float ss = 0.f;
#pragma unroll
                for (int j = 0; j < 4; ++j) { y0[j] = b0[j] * v0[j] * g0[j] * sigmoidf_(g0[j]); y1[j] = b1[j] * v1[j] * g1[j] * sigmoidf_(g1[j]); ss += y0[j] * y0[j] + y1[j] * y1[j]; }
                ss += __shfl_xor(ss, 1); ss += __shfl_xor(ss, 2); ss += __shfl_xor(ss, 4); ss += __shfl_xor(ss, 8);
                const float sc = rsqrtf(ss * (1.0f / 128.0f) + 1e-6f);
                *(u32x4*)(ymix + (size_t)(row0 + r) * DM + DL + ch0) = pack8(y0 * sc * gn0, y1 * sc * gn1);
            }
        }
    }
}

__device__ void phase4(const Params& P, int l) {
    int tid_ = threadIdx.x; asm volatile("" : "+v"(tid_));
    const int lane = tid_ & 63, wv = (blockIdx.x * 512 + tid_) >> 6, nwv = gridDim.x * 8;
    const float* lg = P.in[22] + l * DM; const float* lb = P.in[23] + l * DM;
    bf16_t* xb = (bf16_t*)(P.ws + WS_XB);
    for (int row = wv; row < MT; row += nwv) {
        float* rp = P.out + (size_t)row * DM;
        f32x4 v[8]; float s = 0.f;
#pragma unroll
        for (int i = 0; i < 8; ++i) { v[i] = *(const f32x4*)(rp + i * 256 + lane * 4); s += (v[i][0] + v[i][1]) + (v[i][2] + v[i][3]); }
#pragma unroll
        for (int o = 32; o >= 1; o >>= 1) s += __shfl_xor(s, o);
        const float mean = s * (1.0f / DM); float q = 0.f;
#pragma unroll
        for (int i = 0; i < 8; ++i) { v[i] = v[i] - mean; q += (v[i][0] * v[i][0] + v[i][1] * v[i][1]) + (v[i][2] * v[i][2] + v[i][3] * v[i][3]); }
#pragma unroll
        for (int o = 32; o >= 1; o >>= 1) q += __shfl_xor(q, o);
        const float rstd = rsqrtf(q * (1.0f / DM) + 1e-5f);
#pragma unroll
        for (int i = 0; i < 8; ++i) { const int col = i * 256 + lane * 4;
            const f32x4 y = v[i] * rstd * *(const f32x4*)(lg + col) + *(const f32x4*)(lb + col);
            *(f32x4*)(rp + col) = y;
            if (l + 1 < NLAYER) { u32x2 w; w.x = cvt_pk_bf16(y[0], y[1]); w.y = cvt_pk_bf16(y[2], y[3]); *(u32x2*)(xb + (size_t)row * DM + col) = w; } }
    }
}


#define XB_TMO      128
#define XB_XCNT(j)  (256  + 64 * (j))
#define XB_XSUB(j)  (1280 + 64 * (j))
#define XB_XGEN(j)  (2304 + 64 * (j))
#define XB_TOP      3328
#define XB_TOPGEN   3392
#define XCD_BAR_WORDS 3456
#define XB_SPIN_CAP (1u << 18)
__device__ __forceinline__ unsigned xb_ld(unsigned* p)              { return __hip_atomic_load(p, __ATOMIC_RELAXED, __HIP_MEMORY_SCOPE_AGENT); }
__device__ __forceinline__ unsigned xb_add(unsigned* p, unsigned v) { return __hip_atomic_fetch_add(p, v, __ATOMIC_RELAXED, __HIP_MEMORY_SCOPE_AGENT); }
__device__ __forceinline__ unsigned xb_xcc_id() { return (unsigned)__builtin_amdgcn_s_getreg((3 << 11) | 20) & 0xFu; }
#define XB_SPIN(cond, bar) do { unsigned _sp = 0; while (cond) { __builtin_amdgcn_s_sleep(1); \
    if ((++_sp & 255u) == 0u) { if (xb_ld(&(bar)[XB_TMO])) break; if (_sp > XB_SPIN_CAP) { atomicAdd(&(bar)[XB_TMO], 1u); break; } } } } while (0)
struct XcdBarrier { unsigned* bar; unsigned x; volatile LAS unsigned* st; };
__device__ __forceinline__ XcdBarrier xcd_barrier_post(unsigned* bar, volatile LAS unsigned* st) {
    XcdBarrier b; b.bar = bar; b.x = xb_xcc_id(); b.st = st;
    if (threadIdx.x == 0) (void)xb_add(&bar[XB_XCNT(b.x)], 1u);
    return b;
}
__device__ __forceinline__ void xcd_barrier_complete(unsigned* bar, unsigned x, unsigned& nloc, unsigned& nx) {
    const unsigned G = gridDim.x * gridDim.y * gridDim.z;
    unsigned sum, cnt, mine, sp = 0u;
    for (;;) {
        sum = 0u; cnt = 0u; mine = 0u;
#pragma unroll
        for (unsigned j = 0; j < 16; ++j) { const unsigned c = xb_ld(&bar[XB_XCNT(j)]); sum += c; cnt += (c > 0u) ? 1u : 0u; mine = (j == x) ? c : mine; }
        if (sum == G) break;
        __builtin_amdgcn_s_sleep(1);
        if ((++sp & 255u) == 0u) { if (xb_ld(&bar[XB_TMO])) break; if (sp > XB_SPIN_CAP) { atomicAdd(&bar[XB_TMO], 1u); break; } }
    }
    nloc = mine > 0u ? mine : 1u; nx = cnt > 0u ? cnt : 1u;
}
__device__ __forceinline__ void xcd_barrier(const XcdBarrier& b) {
    asm volatile("s_waitcnt vmcnt(0)" ::: "memory");
    __syncthreads();
    if (threadIdx.x == 0) {
        unsigned* bar = b.bar;
        __builtin_amdgcn_s_waitcnt(0);
        unsigned nloc = b.st[0], nx = b.st[1];
        if (nloc == 0u) { xcd_barrier_complete(bar, b.x, nloc, nx); b.st[0] = nloc; b.st[1] = nx; }
        const unsigned old = xb_add(&bar[XB_XSUB(b.x)], 1u);
        const unsigned gen = old / nloc;
        if (old + 1u == (gen + 1u) * nloc) {
            __builtin_amdgcn_fence(__ATOMIC_RELEASE, "agent");
            asm volatile("s_waitcnt vmcnt(0)" ::: "memory");
            const unsigned og = xb_add(&bar[XB_TOP], 1u);
            const unsigned tg = og / nx;
            if (og + 1u == (tg + 1u) * nx) xb_add(&bar[XB_TOPGEN], 1u);
            else XB_SPIN(xb_ld(&bar[XB_TOPGEN]) == tg, bar);
            __builtin_amdgcn_fence(__ATOMIC_ACQUIRE, "agent");
            xb_add(&bar[XB_XGEN(b.x)], 1u);
            asm volatile("s_waitcnt vmcnt(0)" ::: "memory");
        } else {
            XB_SPIN(xb_ld(&bar[XB_XGEN(b.x)]) == gen, bar);
            __builtin_amdgcn_fence(__ATOMIC_ACQUIRE, "agent");
            asm volatile("s_waitcnt vmcnt(0)" ::: "memory");
        }
    }
    __syncthreads();
}

__global__ void __launch_bounds__(512, 2) mega_fwd(Params P) {
    extern __shared__ __attribute__((aligned(16))) unsigned char lds_raw[];
    LAS unsigned char* lds = (LAS unsigned char*)lds_raw;
    cg::grid_group grid = cg::this_grid();
    unsigned char* ws = P.ws;
    int ph = 0;
    if (threadIdx.x < 4) ((LAS unsigned*)(lds + 131072))[threadIdx.x] = 0u;
    __syncthreads();
    XcdBarrier xbar = xcd_barrier_post((unsigned*)(ws + WS_BAR), (volatile LAS unsigned*)(lds + 131072));
#ifndef PROBE_PH
#define PROBE_PH -1
#endif
#define RUN(k) ((k) >= P.ph_lo && (k) < P.ph_hi)
#define SEAM(k) do { if ((k) + 1 < P.ph_hi) xcd_barrier(xbar); } while (0)
#define REPS(k) (((k) == PROBE_PH) ? 2 : 1)
    if (RUN(ph)) { for (int rp = 0; rp < REPS(0); ++rp) { phase0(P, lds); if (ph + 1 < P.ph_hi) grid.sync(); } } ++ph;
#pragma unroll 1
    for (int l = 0; l < NLAYER; ++l) {
        if (RUN(ph)) for (int rp = 0; rp < REPS(1 + (l == 0 ? 0 : 100)); ++rp) {
            { pg8::Gemm g{(const bf16_t*)(ws + WS_XB), (const bf16_t*)(ws + WS_WIN) + (size_t)l * NIN * DM, MT, NIN, DM};
              pg8::StaticOrder S; S.init(MT, NIN, gridDim.x, blockIdx.x);
              pg8::EpiBf16 E{(bf16_t*)(ws + WS_Z), NIN};
              pg8::gemm_phase(lds, g, S, E); }
            { pg8::Gemm g{(const bf16_t*)(ws + WS_PB) + (size_t)l * MT * DPLE, (const bf16_t*)(ws + WS_WP) + (size_t)l * DM * DPLE, MT, DM, DPLE};
              const int skip = (34 * 24) % (int)gridDim.x;
              pg8::StaticOrder S; S.init(MT, DM, (int)gridDim.x - skip, (int)blockIdx.x - skip);
              pg8::EpiBf16 E{(bf16_t*)(ws + WS_E), DM};
              pg8::gemm_phase(lds, g, S, E); }
            SEAM(ph);
        } ++ph;
        if (RUN(ph)) for (int rp = 0; rp < REPS(2 + (l == 0 ? 0 : 100)); ++rp) { phase2a(P, l, lds); SEAM(ph); } ++ph;
        if (RUN(ph)) for (int rp = 0; rp < REPS(3 + (l == 0 ? 0 : 100)); ++rp) { phase2c(P, l, lds); SEAM(ph); } ++ph;
        if (RUN(ph)) for (int rp = 0; rp < REPS(4 + (l == 0 ? 0 : 100)); ++rp) {
            pg8::Gemm g{(const bf16_t*)(ws + WS_YMIX), (const bf16_t*)(ws + WS_WOUT) + (size_t)l * DM * DM, MT, DM, DM};
            pg8::StaticOrder S; S.init(MT, DM, gridDim.x, blockIdx.x);
            pg8::EpiRes E{l == 0 ? P.in[0] : P.out, l == 0 ? P.in[1] : P.out + (size_t)NPR * DM, P.out, (bf16_t*)(ws + WS_RB)};
            pg8::gemm_phase(lds, g, S, E);
            SEAM(ph);
        } ++ph;
        if (RUN(ph)) {
            pg8::Gemm g{(const bf16_t*)(ws + WS_RB), (const bf16_t*)(ws + WS_WG) + (size_t)l * DM * DM, MT, DM, DM};
            pg8::StaticOrder S; S.init(MT, DM, gridDim.x, blockIdx.x);
            pg8::EpiGate E{P.out, (const bf16_t*)(ws + WS_E), P.in[21] + l * DM};
            pg8::gemm_phase(lds, g, S, E);
            SEAM(ph);
        } ++ph;
        if (RUN(ph)) { phase4(P, l); SEAM(ph); } ++ph;
    }
}
constexpr int N_PHASES = 1 + 6 * NLAYER;
constexpr int LDS_BYTES = 131072 + 16;

extern "C" void kernel_launch(void* const* d_in, const int* in_sizes, int n_in, void* d_out, int out_size, void* d_ws, size_t ws_size, hipStream_t stream) {
    static int grid = 0;
    if (grid == 0) {
        if (n_in != 24 || ws_size < WS_END) { fprintf(stderr, "kernel_launch: need 24 inputs and >= %zu bytes of workspace (got %d, %zu)\n", (size_t)WS_END, n_in, ws_size); grid = -1; return; }
        int dev = 0, cus = 0, per_cu = 0;
        hipGetDevice(&dev); hipDeviceGetAttribute(&cus, hipDeviceAttributeMultiprocessorCount, dev);
        if (hipFuncSetAttribute((const void*)mega_fwd, hipFuncAttributeMaxDynamicSharedMemorySize, LDS_BYTES) != hipSuccess) { fprintf(stderr, "kernel_launch: hipFuncSetAttribute failed\n"); grid = -1; return; }
        if (hipOccupancyMaxActiveBlocksPerMultiprocessor(&per_cu, (const void*)mega_fwd, 512, LDS_BYTES) != hipSuccess || per_cu < 1) { fprintf(stderr, "kernel_launch: occupancy query failed (%d)\n", per_cu); grid = -1; return; }
        grid = cus * per_cu;
        fprintf(stderr, "kernel_launch: grid %d (%d CUs x %d)\n", grid, cus, per_cu);
    }
    if (grid < 0) return;
    if (hipMemsetAsync((char*)d_ws + WS_BAR, 0, XCD_BAR_WORDS * 4, stream) != hipSuccess) { fprintf(stderr, "kernel_launch: memset failed\n"); return; }
    Params p{};
    for (int i = 0; i < 24; ++i) p.in[i] = (const float*)d_in[i];
    p.out = (float*)d_out; p.ws = (unsigned char*)d_ws; p.ph_lo = 0; p.ph_hi = N_PHASES;
    void* args[] = {&p};
    hipError_t e = hipLaunchCooperativeKernel((const void*)mega_fwd, dim3(grid), dim3(512), args, LDS_BYTES, stream);
    if (e != hipSuccess) fprintf(stderr, "kernel_launch: cooperative launch failed: %s (grid %d)\n", hipGetErrorString(e), grid);
}
```

```cpp
#include <hip/hip_runtime.h>
#include <hip/hip_cooperative_groups.h>
#include <cstdio>
namespace cg = cooperative_groups;

#define LAS __attribute__((address_space(3)))
typedef unsigned short bf16_t;
typedef short bf16x8 __attribute__((ext_vector_type(8)));
typedef float f32x4 __attribute__((ext_vector_type(4)));
typedef unsigned u32x4 __attribute__((ext_vector_type(4)));
typedef unsigned u32x2 __attribute__((ext_vector_type(2)));

constexpr int DM = 2048, NPR = 8192, NSR = 512, MT = 8704, NLAYER = 2, DL = 1024, NIN = 6144, DPLE = 256, SEQ = 2048, NB = 4, DB = 128;
constexpr float ALPHA = 1.4142135623730951f;
constexpr size_t O_Y = 0, O_LH_P = (size_t)MT * DM, O_LC_P = O_LH_P + 2 * 4 * 1024, O_SC_P = O_LC_P + 2 * 4 * 3 * 1024,
                 O_LH_S = O_SC_P + 2 * 4 * 2 * 1024, O_LC_S = O_LH_S + 2 * 128 * 1024, O_SC_S = O_LC_S + 2 * 128 * 3 * 1024;
constexpr size_t SZ_ACT = (size_t)MT * DM * 2;
constexpr size_t WS_XB = 0, WS_PB = WS_XB + SZ_ACT, WS_WIN = WS_PB + (size_t)2 * MT * 256 * 2, WS_WOUT = WS_WIN + (size_t)2 * NIN * DM * 2,
                 WS_WG = WS_WOUT + (size_t)2 * DM * DM * 2, WS_WP = WS_WG + (size_t)2 * DM * DM * 2, WS_WA = WS_WP + (size_t)2 * DM * 256 * 2,
                 WS_WX = WS_WA + 524288, WS_SUM = WS_WX + 524288, WS_Z = WS_SUM + 1048576, WS_HL = WS_Z + (size_t)MT * NIN * 2,
                 WS_PP = WS_HL + SZ_ACT, WS_YMIX = WS_PP + SZ_ACT, WS_E = WS_YMIX + SZ_ACT, WS_BAR = WS_E + SZ_ACT, WS_END = WS_BAR + 16384;
constexpr size_t WS_RB = WS_HL;

struct Params { const float* in[24]; float* out; unsigned char* ws; int ph_lo, ph_hi; };
#define CAS __attribute__((address_space(4)))
__device__ __forceinline__ const CAS Params& kparams() { const CAS Params* p = (const CAS Params*)__builtin_amdgcn_kernarg_segment_ptr(); asm volatile("" : "+s"(p)); return *p; }

__device__ __forceinline__ unsigned cvt_pk_bf16(float lo, float hi) { unsigned r; asm volatile("v_cvt_pk_bf16_f32 %0, %1, %2" : "=v"(r) : "v"(lo), "v"(hi)); return r; }
__device__ __forceinline__ float bf_lo(unsigned w) { return __uint_as_float(w << 16); }
__device__ __forceinline__ float bf_hi(unsigned w) { return __uint_as_float(w & 0xffff0000u); }
__device__ __forceinline__ float sigmoidf_(float x) { return 1.0f / (1.0f + __expf(-x)); }
__device__ __forceinline__ u32x4 pack8(const f32x4 a, const f32x4 b) { u32x4 w; w.x = cvt_pk_bf16(a[0], a[1]); w.y = cvt_pk_bf16(a[2], a[3]); w.z = cvt_pk_bf16(b[0], b[1]); w.w = cvt_pk_bf16(b[2], b[3]); return w; }
__device__ __forceinline__ void unpack8_(const u32x4 q, f32x4& lo, f32x4& hi) { lo = (f32x4){bf_lo(q[0]), bf_hi(q[0]), bf_lo(q[1]), bf_hi(q[1])}; hi = (f32x4){bf_lo(q[2]), bf_hi(q[2]), bf_lo(q[3]), bf_hi(q[3])}; }
#define UNPACK8(q_, lo_, hi_) unpack8_(q_, lo_, hi_)

namespace pg8 {
constexpr int BM = 256, BK = 64, HALF = 128, HTB = HALF * BK * 2, STAGE_BYTES = 8 * HTB, NXCD = 8, WGM = 8;
__host__ __device__ __forceinline__ int lds_byte(int r, int c) { const int st = (r >> 4) * 2 + (c >> 5), rr = r & 15, cc = c & 31, ob = rr * 64 + cc * 2; return st * 1024 + (ob ^ (((ob >> 9) & 1) << 5)); }
__host__ __device__ __forceinline__ void stage_rc(int b, int& R, int& C) { const int st = b / 1024, sb = b % 1024, swz = sb ^ (((sb >> 9) & 1) << 5); R = (st >> 1) * 16 + swz / 64; C = (st & 1) * 32 + (swz % 64) / 2; }
__host__ __device__ __forceinline__ int perm32(int rho) { const int n = rho >> 4, i = rho & 15; return 8 * (i >> 2) + 4 * n + (i & 3); }
struct Unit { int pm, pn; };
struct Gemm { const bf16_t* A; const bf16_t* Bt; int M, N, K; };
struct StaticOrder {
    int nM, nN, nwg, G, c;
    __device__ void init(int M, int N, int G_, int c_) { nM = M / BM; nN = N / BM; nwg = nM * nN; G = G_; c = c_; }
    __device__ bool next(int i, Unit& u) const {
        const long L = (long)i * G + c; if (L >= nwg || c < 0) return false;
        int wgid = (int)L; { const int q = nwg / NXCD, r = nwg % NXCD, xcd = wgid % NXCD, off = wgid / NXCD; wgid = (xcd < r ? xcd * (q + 1) : r * (q + 1) + (xcd - r) * q) + off; }
        const int nig = WGM * nN, gid = wgid / nig, fm = gid * WGM, gsz = (nM - fm) < WGM ? (nM - fm) : WGM;
        u.pm = fm + ((wgid % nig) % gsz); u.pn = (wgid % nig) / gsz; return true;
    }
};
struct EpiBf16 {
    bf16_t* O; int ldc;
    __device__ __forceinline__ void emit(int row, int col, const f32x4 v0, const f32x4 v1) const { *(u32x4*)(O + (size_t)row * ldc + col) = pack8(v0, v1); }
};
struct EpiRes {
    const bf16_t* xb; bf16_t* rb;
    __device__ __forceinline__ void emit(int row, int col, const f32x4 v0, const f32x4 v1) const {
        const size_t off = (size_t)row * DM + col; const u32x4 xw = *(const u32x4*)(xb + off); f32x4 x0, x1; UNPACK8(xw, x0, x1);
        *(u32x4*)(rb + off) = pack8(v0 + ALPHA * x0, v1 + ALPHA * x1); }
};
struct EpiGate {
    const bf16_t* rb; const bf16_t* e; const float* bg; bf16_t* tb;
    __device__ __forceinline__ void emit(int row, int col, const f32x4 v0, const f32x4 v1) const {
        const size_t off = (size_t)row * DM + col;
        const u32x4 rw = *(const u32x4*)(rb + off), ew = *(const u32x4*)(e + off); f32x4 r0, r1, e0, e1; UNPACK8(rw, r0, r1); UNPACK8(ew, e0, e1);
        f32x4 g0 = v0 + *(const f32x4*)(bg + col), g1 = v1 + *(const f32x4*)(bg + col + 4);
#pragma unroll
        for (int j = 0; j < 4; ++j) { g0[j] = sigmoidf_(g0[j]); g1[j] = sigmoidf_(g1[j]); }
        *(u32x4*)(tb + off) = pack8(r0 + g0 * e0, r1 + g1 * e1); }
};

template <class Epi, class Sched>
__device__ __forceinline__ void gemm_phase(LAS unsigned char* lds, const Gemm g, const Sched& S, const Epi& E) {
    int tid_ = threadIdx.x; asm volatile("" : "+v"(tid_));
    const int tid = tid_, wid = __builtin_amdgcn_readfirstlane(tid >> 6), lane = tid & 63, wr = wid >> 2, wc = wid & 3, fr = lane & 15, fq = lane >> 4;
    const int K = g.K, nt = K / BK;
    unsigned voffA, voffB;
    { int R, C; stage_rc(tid * 16, R, C); const int Rb = (R & ~31) + perm32(R & 31); voffA = (unsigned)(R * K + C) * 2u; voffB = (unsigned)(Rb * K + C) * 2u; }
    const size_t qstep = (size_t)64 * K * 2;
    const size_t kstep = (size_t)(BK * 2);
    const size_t hstep = (size_t)HALF * K * 2;
    const size_t tstep = 2 * hstep;
    const unsigned ldsw = (unsigned)wid * 1024u;
    const int aoff = lds_byte(wr * 64 + fr, fq * 8), boff = lds_byte(wc * 32 + fr, fq * 8);
    const unsigned xoff = (unsigned)(fr * K + fq * 8) * 2u;
#define PG8_SA(b, h) (((b) * 2 + (h)) * HTB)
#define PG8_SB(b, h) ((4 + (b) * 2 + (h)) * HTB)
#define PG8_STAGE(bufoff, gbase, voff) do { _Pragma("unroll") for (int _i = 0; _i < 2; ++_i) \
        __builtin_amdgcn_global_load_lds((const unsigned*)((const char*)(gbase) + _i * qstep + (voff)), (LAS unsigned*)(lds + (bufoff) + ldsw + _i * 8192), 16, 0, 0); } while (0)
#define PG8_LDA(dst, b, h) do { _Pragma("unroll") for (int m = 0; m < 4; ++m) _Pragma("unroll") for (int k = 0; k < 2; ++k) dst[m][k] = *(const LAS bf16x8*)(lds + PG8_SA(b, h) + aoff + m * 2048 + k * 1024); } while (0)
#define PG8_LDB(dst, b, h) do { _Pragma("unroll") for (int n = 0; n < 2; ++n) _Pragma("unroll") for (int k = 0; k < 2; ++k) dst[n][k] = *(const LAS bf16x8*)(lds + PG8_SB(b, h) + boff + n * 2048 + k * 1024); } while (0)
#define PG8_MMA(ai, bj, At, Bt) do { __builtin_amdgcn_s_setprio(1); _Pragma("unroll") for (int m = 0; m < 4; ++m) _Pragma("unroll") for (int n = 0; n < 2; ++n) _Pragma("unroll") for (int k = 0; k < 2; ++k) \
        acc[ai][bj][m][n] = __builtin_amdgcn_mfma_f32_16x16x32_bf16(Bt[n][k], At[m][k], acc[ai][bj][m][n], 0, 0, 0); __builtin_amdgcn_s_setprio(0); } while (0)
#define PG8_LDX(kt) do { const char* _x = cX + (size_t)(kt) * kstep; ax[0] = *(const bf16x8*)(_x + xoff); ax[1] = *(const bf16x8*)(_x + 64 + xoff); } while (0)
#define PG8_XMMA() do { if (wr == 0) { _Pragma("unroll") for (int n = 0; n < 2; ++n) _Pragma("unroll") for (int k = 0; k < 2; ++k) accx[n] = __builtin_amdgcn_mfma_f32_16x16x32_bf16(B0[n][k], ax[k], accx[n], 0, 0, 0); } \
        else { _Pragma("unroll") for (int n = 0; n < 2; ++n) _Pragma("unroll") for (int k = 0; k < 2; ++k) accx[n] = __builtin_amdgcn_mfma_f32_16x16x32_bf16(B1[n][k], ax[k], accx[n], 0, 0, 0); } } while (0)
#define PG8_WAIT_V(n) asm volatile("s_waitcnt vmcnt(" #n ")" ::: "memory")
#define PG8_WAIT_L(n) asm volatile("s_waitcnt lgkmcnt(" #n ")" ::: "memory")
#define PG8_BAR __builtin_amdgcn_s_barrier()
#define PG8_SCHED __builtin_amdgcn_sched_barrier(0)
    Unit cur, nxt; int ui = 0;
    if (!S.next(0, cur)) return;
    f32x4 acc[2][2][4][2], accx[2];
#pragma unroll
    for (int a = 0; a < 2; ++a)
#pragma unroll
        for (int b = 0; b < 2; ++b)
#pragma unroll
            for (int m = 0; m < 4; ++m)
#pragma unroll
                for (int n = 0; n < 2; ++n) acc[a][b][m][n] = (f32x4){0.f, 0.f, 0.f, 0.f};
    accx[0] = (f32x4){0.f, 0.f, 0.f, 0.f}; accx[1] = accx[0];
    bf16x8 At[4][2], B0[2][2], B1[2][2], ax[2];
    const char* cA = (const char*)g.A + (size_t)cur.pm * tstep; const char* cB = (const char*)g.Bt + (size_t)cur.pn * tstep;
    const char* cX = (const char*)g.A + ((size_t)NPR + 16 * cur.pm) * K * 2;
    PG8_STAGE(PG8_SB(0, 0), cB, voffB); PG8_STAGE(PG8_SA(0, 0), cA, voffA); PG8_STAGE(PG8_SB(0, 1), cB + hstep, voffB); PG8_STAGE(PG8_SA(0, 1), cA + hstep, voffA);
    if (wr == 1) PG8_BAR;
    PG8_WAIT_V(4); PG8_BAR;
    PG8_STAGE(PG8_SB(1, 0), cB + kstep, voffB); PG8_STAGE(PG8_SA(1, 0), cA + kstep, voffA); PG8_STAGE(PG8_SB(1, 1), cB + hstep + kstep, voffB);
    PG8_WAIT_V(6); PG8_BAR;
    for (;;) {
        const bool has_next = S.next(ui + 1, nxt);
        const char* nA = has_next ? (const char*)g.A + (size_t)nxt.pm * tstep : cA; const char* nB = has_next ? (const char*)g.Bt + (size_t)nxt.pn * tstep : cB;
        for (int t = 0; t < nt; t += 2) {
            const bool last = (t == nt - 2);
            const char* a1 = cA + (size_t)(t + 1) * kstep;
            const char* a2 = last ? nA : cA + (size_t)(t + 2) * kstep; const char* b2 = last ? nB : cB + (size_t)(t + 2) * kstep;
            const char* a3 = a2 + kstep; const char* b3 = b2 + kstep;
            PG8_LDB(B0, 0, 0); PG8_SCHED; PG8_LDA(At, 0, 0); PG8_STAGE(PG8_SA(1, 1), a1 + hstep, voffA); PG8_LDX(t);
            PG8_WAIT_L(8); PG8_BAR; PG8_WAIT_L(0); PG8_MMA(0, 0, At, B0); PG8_BAR; PG8_SCHED;
            PG8_LDB(B1, 0, 1); PG8_STAGE(PG8_SB(0, 0), b2, voffB);
            PG8_BAR; PG8_WAIT_L(0); PG8_MMA(0, 1, At, B1); PG8_BAR;
            PG8_LDA(At, 0, 1); PG8_STAGE(PG8_SA(0, 0), a2, voffA);
            PG8_BAR; PG8_WAIT_L(0); PG8_MMA(1, 0, At, B0); PG8_BAR; PG8_SCHED;
            PG8_STAGE(PG8_SB(0, 1), b2 + hstep, voffB);
            PG8_WAIT_V(6); PG8_BAR; PG8_MMA(1, 1, At, B1); PG8_XMMA(); PG8_BAR; PG8_SCHED;
            PG8_LDB(B0, 1, 0); PG8_SCHED; PG8_LDA(At, 1, 0); PG8_STAGE(PG8_SA(0, 1), a2 + hstep, voffA); PG8_LDX(t + 1);
            PG8_WAIT_L(8); PG8_BAR; PG8_WAIT_L(0); PG8_MMA(0, 0, At, B0); PG8_BAR; PG8_SCHED;
            PG8_LDB(B1, 1, 1); PG8_STAGE(PG8_SB(1, 0), b3, voffB);
            PG8_BAR; PG8_WAIT_L(0); PG8_MMA(0, 1, At, B1); PG8_BAR;
            PG8_LDA(At, 1, 1); PG8_STAGE(PG8_SA(1, 0), a3, voffA);
            PG8_BAR; PG8_WAIT_L(0); PG8_MMA(1, 0, At, B0); PG8_BAR; PG8_SCHED;
            PG8_STAGE(PG8_SB(1, 1), b3 + hstep, voffB);
            PG8_WAIT_V(6); PG8_BAR; PG8_MMA(1, 1, At, B1); PG8_XMMA(); PG8_BAR; PG8_SCHED;
        }
        {
            const int row0 = cur.pm * BM + wr * 64 + fr, col0 = cur.pn * BM + wc * 32 + 8 * fq;
#pragma unroll
            for (int ai = 0; ai < 2; ++ai)
#pragma unroll
                for (int m = 0; m < 4; ++m) {
#pragma unroll
                    for (int bj = 0; bj < 2; ++bj) E.emit(row0 + ai * HALF + m * 16, col0 + bj * HALF, acc[ai][bj][m][0], acc[ai][bj][m][1]);
                    asm volatile("" ::: "memory"); }
            E.emit(NPR + 16 * cur.pm + fr, col0 + wr * HALF, accx[0], accx[1]);
        }
        if (!has_next) break;
#pragma unroll
        for (int a = 0; a < 2; ++a)
#pragma unroll
            for (int b = 0; b < 2; ++b)
#pragma unroll
                for (int m = 0; m < 4; ++m)
#pragma unroll
                    for (int n = 0; n < 2; ++n) acc[a][b][m][n] = (f32x4){0.f, 0.f, 0.f, 0.f};
        accx[0] = (f32x4){0.f, 0.f, 0.f, 0.f}; accx[1] = accx[0];
        cur = nxt; cA = nA; cB = nB; ++ui;
        cX = (const char*)g.A + ((size_t)NPR + 16 * cur.pm) * K * 2;
    }
    PG8_WAIT_V(0);
    if (wr == 0) PG8_BAR;
    PG8_BAR;
#undef PG8_SA
#undef PG8_SB
#undef PG8_STAGE
#undef PG8_LDA
#undef PG8_LDB
#undef PG8_MMA
#undef PG8_LDX
#undef PG8_XMMA
#undef PG8_WAIT_V
#undef PG8_WAIT_L
#undef PG8_BAR
#undef PG8_SCHED
}
}

__device__ __forceinline__ void cvt_rows(const float* __restrict__ srcA, size_t nA8, const float* __restrict__ srcB, size_t nB8, bf16_t* __restrict__ dst) {
    const size_t n8 = nA8 + nB8;
    for (size_t i = (size_t)blockIdx.x * 512 + threadIdx.x; i < n8; i += (size_t)gridDim.x * 512) {
        const float* s = (i < nA8) ? srcA + i * 8 : srcB + (i - nA8) * 8;
        const f32x4 a = *(const f32x4*)s, b = *(const f32x4*)(s + 4);
        *(u32x4*)(dst + i * 8) = pack8(a, b);
    }
}
__device__ __forceinline__ void tr_tile(const float* __restrict__ src, bf16_t* __restrict__ dst, int R, int C, int idx, LAS float* tile) {
    int tid_ = threadIdx.x; asm volatile("" : "+v"(tid_));
    const int tid = tid_, ntc = C >> 6, tr = idx / ntc, tc = idx - tr * ntc;
#pragma unroll
    for (int i = 0; i < 2; ++i) { const int e = tid + 512 * i, row = e >> 4, c4 = e & 15;
        const f32x4 v = *(const f32x4*)(src + (size_t)(tr * 64 + row) * C + tc * 64 + c4 * 4);
#pragma unroll
        for (int j = 0; j < 4; ++j) tile[row * 65 + c4 * 4 + j] = v[j]; }
    __syncthreads();
    { const int cc = tid >> 3, r0 = (tid & 7) * 8; f32x4 a, b;
#pragma unroll
      for (int j = 0; j < 4; ++j) { a[j] = tile[(r0 + j) * 65 + cc]; b[j] = tile[(r0 + 4 + j) * 65 + cc]; }
      *(u32x4*)(dst + (size_t)(tc * 64 + cc) * R + tr * 64 + r0) = pack8(a, b); }
    __syncthreads();
}
__device__ __forceinline__ void phase0(LAS unsigned char* lds) {
    const CAS Params& P = kparams();
    unsigned char* ws = P.ws;
    cvt_rows(P.in[0], (size_t)NPR * DM / 8, P.in[1], (size_t)NSR * DM / 8, (bf16_t*)(ws + WS_XB));
    for (int l = 0; l < NLAYER; ++l)
        cvt_rows(P.in[5] + (size_t)l * NPR * DPLE, (size_t)NPR * DPLE / 8, P.in[6] + (size_t)l * NSR * DPLE, (size_t)NSR * DPLE / 8, (bf16_t*)(ws + WS_PB) + (size_t)l * MT * DPLE);
    LAS float* tile = (LAS float*)lds;
    constexpr int T_IN = 32 * 96, T_SQ = 32 * 32, T_WP = 4 * 32, T_HD = 4;
    constexpr int E0 = 2 * T_IN, E1 = E0 + 2 * T_SQ, E2 = E1 + 2 * T_SQ, E3 = E2 + 2 * T_WP, E4 = E3 + 16 * T_HD, E5 = E4 + 16 * T_HD;
    for (int T = blockIdx.x; T < E5; T += gridDim.x) {
        if (T < E0) { const int l = T / T_IN, i = T - l * T_IN; tr_tile(P.in[7] + (size_t)l * DM * NIN, (bf16_t*)(ws + WS_WIN) + (size_t)l * NIN * DM, DM, NIN, i, tile); }
        else if (T < E1) { const int t = T - E0, l = t / T_SQ, i = t - l * T_SQ; tr_tile(P.in[18] + (size_t)l * DM * DM, (bf16_t*)(ws + WS_WOUT) + (size_t)l * DM * DM, DM, DM, i, tile); }
        else if (T < E2) { const int t = T - E1, l = t / T_SQ, i = t - l * T_SQ; tr_tile(P.in[20] + (size_t)l * DM * DM, (bf16_t*)(ws + WS_WG) + (size_t)l * DM * DM, DM, DM, i, tile); }
        else if (T < E3) { const int t = T - E2, l = t / T_WP, i = t - l * T_WP; tr_tile(P.in[19] + (size_t)l * DPLE * DM, (bf16_t*)(ws + WS_WP) + (size_t)l * DM * DPLE, DPLE, DM, i, tile); }
        else if (T < E4) { const int t = T - E3, mtx = t >> 2, i = t & 3; tr_tile(P.in[10] + (size_t)mtx * 16384, (bf16_t*)(ws + WS_WA) + (size_t)mtx * 16384, 128, 128, i, tile); }
        else { const int t = T - E4, mtx = t >> 2, i = t & 3; tr_tile(P.in[12] + (size_t)mtx * 16384, (bf16_t*)(ws + WS_WX) + (size_t)mtx * 16384, 128, 128, i, tile); }
    }
}

constexpr int N_LRU_TILES = 4 * 32 * 8 + 8 * 8;
__device__ __forceinline__ void phase2a(int l, LAS unsigned char* lds) {
    const CAS Params& P = kparams();
    int tid_ = threadIdx.x; asm volatile("" : "+v"(tid_));
    const int tid = tid_, lane = tid & 63, wid = tid >> 6, fr = lane & 15, fq = lane >> 4;
    LAS bf16_t* xcA = (LAS bf16_t*)lds;
    LAS float* xcF = (LAS float*)(lds + 17408);
    LAS float* aL = (LAS float*)(lds + 17408 + 33792);
    LAS float* uL = aL + 64 * 128;
    LAS float* subA = uL + 64 * 128;
    LAS float* subH = subA + 512;
    const bf16_t* z = (const bf16_t*)(P.ws + WS_Z);
    float* hlb = (float*)(P.ws + WS_HL); float* ppb = (float*)(P.ws + WS_PP); float* summ = (float*)(P.ws + WS_SUM);
    const float* cw = P.in[8] + (size_t)l * 4 * DL; const float* cb = P.in[9] + (size_t)l * DL;
    for (int tile = blockIdx.x; tile < N_LRU_TILES; tile += gridDim.x) {
        const bool smp = tile >= 1024;
        int b = 0, hd, c;
        if (!smp) { hd = tile & 7; c = (tile >> 3) & 31; b = tile >> 8; } else { const int s = tile - 1024; hd = s & 7; c = s >> 3; }
        const int row0 = smp ? NPR + c * 64 : b * SEQ + c * 64;
        {
            const int g = tid & 15, chl = g * 8, ch0 = hd * 128 + chl;
            f32x4 w[4][2], bias[2];
#pragma unroll
            for (int k = 0; k < 4; ++k) { w[k][0] = *(const f32x4*)(cw + k * DL + ch0); w[k][1] = *(const f32x4*)(cw + k * DL + ch0 + 4); }
            bias[0] = *(const f32x4*)(cb + ch0); bias[1] = *(const f32x4*)(cb + ch0 + 4);
#pragma unroll
            for (int it = 0; it < 2; ++it) {
                const int r = (tid >> 4) + it * 32;
                f32x4 a0 = bias[0], a1 = bias[1];
#pragma unroll
                for (int k = 0; k < 4; ++k) {
                    f32x4 x0, x1; bool have = true, fromz = true; int tt;
                    if (!smp) { tt = c * 64 + r - k; have = tt >= 0; } else { tt = (r & 3) - k; fromz = tt >= 0; }
                    if (!have) { x0 = (f32x4){0.f, 0.f, 0.f, 0.f}; x1 = x0; }
                    else if (fromz) { const u32x4 v = *(const u32x4*)(z + (size_t)(row0 + r - k) * NIN + ch0); UNPACK8(v, x0, x1); }
                    else { const int sq = c * 16 + (r >> 2); const float* sp = P.in[3] + ((size_t)(l * DB + sq) * 3 + (3 + tt)) * DL + ch0; x0 = *(const f32x4*)sp; x1 = *(const f32x4*)(sp + 4); }
                    a0 += w[3 - k][0] * x0; a1 += w[3 - k][1] * x1;
                    if (k == 0) {
                        if (!smp) { if (c == 31 && r >= 61) { float* o = P.out + O_LC_P + ((size_t)(l * NB + b) * 3 + (r - 61)) * DL + ch0; *(f32x4*)o = x0; *(f32x4*)(o + 4) = x1; } }
                        else if ((r & 3) >= 1) { const int sq = c * 16 + (r >> 2); float* o = P.out + O_LC_S + ((size_t)(l * DB + sq) * 3 + ((r & 3) - 1)) * DL + ch0; *(f32x4*)o = x0; *(f32x4*)(o + 4) = x1; }
                    }
                }
                *(LAS f32x4*)(xcF + r * 132 + chl) = a0; *(LAS f32x4*)(xcF + r * 132 + chl + 4) = a1;
                *(LAS u32x4*)(xcA + r * 136 + chl) = pack8(a0, a1);
            }
        }
        __syncthreads();
        {
            const int n0 = wid * 16, chl = n0 + fr, chg = hd * 128 + chl;
            const bf16_t* waT = (const bf16_t*)(P.ws + WS_WA) + ((size_t)((l * 8 + hd) * 128 + chl)) * 128 + fq * 8;
            const bf16_t* wxT = (const bf16_t*)(P.ws + WS_WX) + ((size_t)((l * 8 + hd) * 128 + chl)) * 128 + fq * 8;
            bf16x8 fa[4], fx[4];
#pragma unroll
            for (int kk = 0; kk < 4; ++kk) { fa[kk] = *(const bf16x8*)(waT + kk * 32); fx[kk] = *(const bf16x8*)(wxT + kk * 32); }
            f32x4 accR[4], accI[4];
#pragma unroll
            for (int m = 0; m < 4; ++m) { accR[m] = (f32x4){0.f, 0.f, 0.f, 0.f}; accI[m] = accR[m]; }
#pragma unroll
            for (int m = 0; m < 4; ++m)
#pragma unroll
                for (int kk = 0; kk < 4; ++kk) {
                    const bf16x8 a = *(const LAS bf16x8*)(xcA + (m * 16 + fr) * 136 + kk * 32 + fq * 8);
                    accR[m] = __builtin_amdgcn_mfma_f32_16x16x32_bf16(a, fa[kk], accR[m], 0, 0, 0);
                    accI[m] = __builtin_amdgcn_mfma_f32_16x16x32_bf16(a, fx[kk], accI[m], 0, 0, 0);
                }
            const float ba = P.in[11][l * DL + chg], bx = P.in[13][l * DL + chg], lam = P.in[14][l * DL + chg];
            const float sp = log1pf(expf(-lam));
#pragma unroll
            for (int m = 0; m < 4; ++m)
#pragma unroll
                for (int j = 0; j < 4; ++j) {
                    const int row = m * 16 + fq * 4 + j;
                    const float rr = sigmoidf_(accR[m][j] + ba), ii = sigmoidf_(accI[m][j] + bx);
                    const float la = -8.0f * rr * sp, a = expf(la), mult = sqrtf(fmaxf(-expm1f(2.0f * la), 0.0f));
                    aL[row * 128 + chl] = a; uL[row * 128 + chl] = mult * ii * xcF[row * 132 + chl];
                }
        }
        __syncthreads();
        {
            const int ch = tid & 127, sub = tid >> 7, chg = hd * 128 + ch;
            if (!smp) {
                float h = 0.f, pr = 1.f;
#pragma unroll 4
                for (int s = 0; s < 16; ++s) { const int t = sub * 16 + s; const float a = aL[t * 128 + ch], u = uL[t * 128 + ch]; h = a * h + u; pr *= a; uL[t * 128 + ch] = h; aL[t * 128 + ch] = pr; }
                subA[sub * 128 + ch] = pr; subH[sub * 128 + ch] = h;
                __syncthreads();
                float carry = 0.f, pref = 1.f;
                for (int j = 0; j < sub; ++j) { const float A = subA[j * 128 + ch]; carry = A * carry + subH[j * 128 + ch]; pref *= A; }
#pragma unroll 4
                for (int s = 0; s < 16; ++s) { const int t = sub * 16 + s; const size_t o = (size_t)(row0 + t) * DL + chg;
                    hlb[o] = uL[t * 128 + ch] + aL[t * 128 + ch] * carry; ppb[o] = aL[t * 128 + ch] * pref; }
                if (sub == 3) { const float A3 = subA[3 * 128 + ch]; float* so = summ + ((size_t)(b * 32 + c) * DL + chg) * 2; so[0] = pref * A3; so[1] = A3 * carry + subH[3 * 128 + ch]; }
            } else {
#pragma unroll
                for (int q = 0; q < 4; ++q) { const int sl = sub * 4 + q, sq = c * 16 + sl;
                    float h = P.in[2][(size_t)(l * DB + sq) * DL + chg];
#pragma unroll
                    for (int t = 0; t < 4; ++t) { const int r = sl * 4 + t; h = aL[r * 128 + ch] * h + uL[r * 128 + ch]; const size_t o = (size_t)(row0 + r) * DL + chg; hlb[o] = h; ppb[o] = 0.f; }
                    P.out[O_LH_S + (size_t)(l * DB + sq) * DL + chg] = h; }
            }
        }
        __syncthreads();
    }
}

__device__ __forceinline__ void phase2c(int l, LAS unsigned char* lds) {
    const CAS Params& P = kparams();
    int tid_ = threadIdx.x; asm volatile("" : "+v"(tid_));
    const int tid = tid_;
    LAS float* carryL = (LAS float*)lds;
    const bf16_t* z = (const bf16_t*)(P.ws + WS_Z);
    const float* hlb = (const float*)(P.ws + WS_HL); const float* ppb = (const float*)(P.ws + WS_PP); const float* summ = (const float*)(P.ws + WS_SUM);
    bf16_t* ymix = (bf16_t*)(P.ws + WS_YMIX);
    for (int tile2 = blockIdx.x; tile2 < 2 * N_LRU_TILES; tile2 += gridDim.x) {
        const bool is_sc = tile2 >= N_LRU_TILES; const int tile = is_sc ? tile2 - N_LRU_TILES : tile2;
        const bool smp = tile >= 1024;
        int b = 0, hd, c;
        if (!smp) { hd = tile & 7; c = (tile >> 3) & 31; b = tile >> 8; } else { const int s = tile - 1024; hd = s & 7; c = s >> 3; }
        const int row0 = smp ? NPR + c * 64 : b * SEQ + c * 64;
        const int g = tid & 15, chl = g * 8, ch0 = hd * 128 + chl;
        if (!is_sc) {
            if (tid < 128) { float carry = 0.f; if (!smp) { const int chg = hd * 128 + tid; for (int j = 0; j < c; ++j) { const float* so = summ + ((size_t)(b * 32 + j) * DL + chg) * 2; carry = so[0] * carry + so[1]; } } carryL[tid] = carry; }
            __syncthreads();
            const f32x4 c0 = *(const LAS f32x4*)(carryL + chl), c1 = *(const LAS f32x4*)(carryL + chl + 4);
            const f32x4 gn0 = *(const f32x4*)(P.in[16] + l * DL + ch0), gn1 = *(const f32x4*)(P.in[16] + l * DL + ch0 + 4);
#pragma unroll
            for (int it = 0; it < 2; ++it) {
                const int r = (tid >> 4) + it * 32; const size_t o = (size_t)(row0 + r) * DL + ch0;
                const f32x4 h0 = *(const f32x4*)(hlb + o) + *(const f32x4*)(ppb + o) * c0, h1 = *(const f32x4*)(hlb + o + 4) + *(const f32x4*)(ppb + o + 4) * c1;
                const u32x4 gw = *(const u32x4*)(z + (size_t)(row0 + r) * NIN + DL + ch0); f32x4 g0, g1; UNPACK8(gw, g0, g1);
                f32x4 y0, y1; float ss = 0.f;
#pragma unroll
                for (int j = 0; j < 4; ++j) { y0[j] = h0[j] * g0[j] * sigmoidf_(g0[j]); y1[j] = h1[j] * g1[j] * sigmoidf_(g1[j]); ss += y0[j] * y0[j] + y1[j] * y1[j]; }
                ss += __shfl_xor(ss, 1); ss += __shfl_xor(ss, 2); ss += __shfl_xor(ss, 4); ss += __shfl_xor(ss, 8);
                const float sc = rsqrtf(ss * (1.0f / 128.0f) + 1e-6f);
                *(u32x4*)(ymix + (size_t)(row0 + r) * DM + ch0) = pack8(y0 * sc * gn0, y1 * sc * gn1);
                if (!smp && c == 31 && r == 63) { float* oh = P.out + O_LH_P + (size_t)(l * NB + b) * DL + ch0; *(f32x4*)oh = h0; *(f32x4*)(oh + 4) = h1; }
            }
            __syncthreads();
        } else {
            const float* sw = P.in[15] + (size_t)l * 3 * DL;
            f32x4 w[3][2];
#pragma unroll
            for (int k = 0; k < 3; ++k) { w[k][0] = *(const f32x4*)(sw + k * DL + ch0); w[k][1] = *(const f32x4*)(sw + k * DL + ch0 + 4); }
            const f32x4 gn0 = *(const f32x4*)(P.in[17] + l * DL + ch0), gn1 = *(const f32x4*)(P.in[17] + l * DL + ch0 + 4);
#pragma unroll
            for (int it = 0; it < 2; ++it) {
                const int r = (tid >> 4) + it * 32;
                f32x4 v0 = (f32x4){0.f, 0.f, 0.f, 0.f}, v1 = v0;
#pragma unroll
                for (int k = 0; k < 3; ++k) {
                    f32x4 q0, q1; bool have = true, fromz = true; int tt;
                    if (!smp) { tt = c * 64 + r - k; have = tt >= 0; } else { tt = (r & 3) - k; fromz = tt >= 0; }
                    if (!have) { q0 = (f32x4){0.f, 0.f, 0.f, 0.f}; q1 = q0; }
                    else if (fromz) { const bf16_t* zr = z + (size_t)(row0 + r - k) * NIN + ch0; const u32x4 cv = *(const u32x4*)(zr + 3 * DL), hv = *(const u32x4*)(zr + 4 * DL);
                        f32x4 cc0, cc1, hh0, hh1; UNPACK8(cv, cc0, cc1); UNPACK8(hv, hh0, hh1); q0 = cc0 * hh0; q1 = cc1 * hh1; }
                    else { const int sq = c * 16 + (r >> 2); const float* sp = P.in[4] + ((size_t)(l * DB + sq) * 2 + (2 + tt)) * DL + ch0; q0 = *(const f32x4*)sp; q1 = *(const f32x4*)(sp + 4); }
                    v0 += w[2 - k][0] * q0; v1 += w[2 - k][1] * q1;
                    if (k == 0) {
                        if (!smp) { if (c == 31 && r >= 62) { float* o = P.out + O_SC_P + ((size_t)(l * NB + b) * 2 + (r - 62)) * DL + ch0; *(f32x4*)o = q0; *(f32x4*)(o + 4) = q1; } }
                        else if ((r & 3) >= 2) { const int sq = c * 16 + (r >> 2); float* o = P.out + O_SC_S + ((size_t)(l * DB + sq) * 2 + ((r & 3) - 2)) * DL + ch0; *(f32x4*)o = q0; *(f32x4*)(o + 4) = q1; }
                    }
                }
                const bf16_t* zr = z + (size_t)(row0 + r) * NIN + ch0;
                const u32x4 bw = *(const u32x4*)(zr + 2 * DL), gw = *(const u32x4*)(zr + 5 * DL);
                f32x4 b0, b1, g0, g1; UNPACK8(bw, b0, b1); UNPACK8(gw, g0, g1);
                f32x4 y0, y1; float ss = 0.f;
#pragma unroll
                for (int j = 0; j < 4; ++j) { y0[j] = b0[j] * v0[j] * g0[j] * sigmoidf_(g0[j]); y1[j] = b1[j] * v1[j] * g1[j] * sigmoidf_(g1[j]); ss += y0[j] * y0[j] + y1[j] * y1[j]; }
                ss += __shfl_xor(ss, 1); ss += __shfl_xor(ss, 2); ss += __shfl_xor(ss, 4); ss += __shfl_xor(ss, 8);
                const float sc = rsqrtf(ss * (1.0f / 128.0f) + 1e-6f);
                *(u32x4*)(ymix + (size_t)(row0 + r) * DM + DL + ch0) = pack8(y0 * sc * gn0, y1 * sc * gn1);
            }
        }
    }
}

__device__ __forceinline__ void phase4(int l) {
    const CAS Params& P = kparams();
    int tid_ = threadIdx.x; asm volatile("" : "+v"(tid_));
    const int lane = tid_ & 63, wv = (blockIdx.x * 512 + tid_) >> 6, nwv = gridDim.x * 8;
    const float* lg = P.in[22] + l * DM; const float* lb = P.in[23] + l * DM;
    bf16_t* xb = (bf16_t*)(P.ws + WS_XB); const bf16_t* tb = (const bf16_t*)(P.ws + WS_YMIX);
    for (int row = wv; row < MT; row += nwv) {
        f32x4 v[8]; float s = 0.f;
#pragma unroll
        for (int i = 0; i < 4; ++i) { const u32x4 w = *(const u32x4*)(tb + (size_t)row * DM + i * 512 + lane * 8); UNPACK8(w, v[2 * i], v[2 * i + 1]); }
#pragma unroll
        for (int i = 0; i < 8; ++i) s += (v[i][0] + v[i][1]) + (v[i][2] + v[i][3]);
#pragma unroll
        for (int o = 32; o >= 1; o >>= 1) s += __shfl_xor(s, o);
        const float mean = s * (1.0f / DM); float q = 0.f;
#pragma unroll
        for (int i = 0; i < 8; ++i) { v[i] = v[i] - mean; q += (v[i][0] * v[i][0] + v[i][1] * v[i][1]) + (v[i][2] * v[i][2] + v[i][3] * v[i][3]); }
#pragma unroll
        for (int o = 32; o >= 1; o >>= 1) q += __shfl_xor(q, o);
        const float rstd = rsqrtf(q * (1.0f / DM) + 1e-5f);
#pragma unroll
        for (int i = 0; i < 4; ++i) { const int col = i * 512 + lane * 8;
            const f32x4 y0 = v[2 * i] * rstd * *(const f32x4*)(lg + col) + *(const f32x4*)(lb + col), y1 = v[2 * i + 1] * rstd * *(const f32x4*)(lg + col + 4) + *(const f32x4*)(lb + col + 4);
            if (l + 1 < NLAYER) *(u32x4*)(xb + (size_t)row * DM + col) = pack8(y0, y1);
            else { float* rp = P.out + (size_t)row * DM + col; *(f32x4*)rp = y0; *(f32x4*)(rp + 4) = y1; } }
    }
}

#define XB_TMO      128
#define XB_XCNT(j)  (256  + 64 * (j))
#define XB_XSUB(j)  (1280 + 64 * (j))
#define XB_XGEN(j)  (2304 + 64 * (j))
#define XB_TOP      3328
#define XB_TOPGEN   3392
#define XCD_BAR_WORDS 3456
#define XB_SPIN_CAP (1u << 18)
__device__ __forceinline__ unsigned xb_ld(unsigned* p)              { return __hip_atomic_load(p, __ATOMIC_RELAXED, __HIP_MEMORY_SCOPE_AGENT); }
__device__ __forceinline__ unsigned xb_add(unsigned* p, unsigned v) { return __hip_atomic_fetch_add(p, v, __ATOMIC_RELAXED, __HIP_MEMORY_SCOPE_AGENT); }
__device__ __forceinline__ unsigned xb_xcc_id() { return (unsigned)__builtin_amdgcn_s_getreg((3 << 11) | 20) & 0xFu; }
#define XB_SPIN(cond, bar) do { unsigned _sp = 0; while (cond) { __builtin_amdgcn_s_sleep(1); \
    if ((++_sp & 255u) == 0u) { if (xb_ld(&(bar)[XB_TMO])) break; if (_sp > XB_SPIN_CAP) { atomicAdd(&(bar)[XB_TMO], 1u); break; } } } } while (0)
struct XcdBarrier { unsigned* bar; unsigned x; volatile LAS unsigned* st; };
__device__ __forceinline__ XcdBarrier xcd_barrier_post(unsigned* bar, volatile LAS unsigned* st) {
    XcdBarrier b; b.bar = bar; b.x = xb_xcc_id(); b.st = st;
    if (threadIdx.x == 0) (void)xb_add(&bar[XB_XCNT(b.x)], 1u);
    return b;
}
__device__ __forceinline__ void xcd_barrier_complete(unsigned* bar, unsigned x, unsigned& nloc, unsigned& nx) {
    const unsigned G = gridDim.x * gridDim.y * gridDim.z;
    unsigned sum, cnt, mine, sp = 0u;
    for (;;) {
        sum = 0u; cnt = 0u; mine = 0u;
#pragma unroll
        for (unsigned j = 0; j < 16; ++j) { const unsigned c = xb_ld(&bar[XB_XCNT(j)]); sum += c; cnt += (c > 0u) ? 1u : 0u; mine = (j == x) ? c : mine; }
        if (sum == G) break;
        __builtin_amdgcn_s_sleep(1);
        if ((++sp & 255u) == 0u) { if (xb_ld(&bar[XB_TMO])) break; if (sp > XB_SPIN_CAP) { atomicAdd(&bar[XB_TMO], 1u); break; } }
    }
    nloc = mine > 0u ? mine : 1u; nx = cnt > 0u ? cnt : 1u;
}
__device__ __forceinline__ void xcd_barrier(const XcdBarrier& b) {
    asm volatile("s_waitcnt vmcnt(0)" ::: "memory");
    __syncthreads();
    if (threadIdx.x == 0) {
        unsigned* bar = b.bar;
        __builtin_amdgcn_s_waitcnt(0);
        unsigned nloc = b.st[0], nx = b.st[1];
        if (nloc == 0u) { xcd_barrier_complete(bar, b.x, nloc, nx); b.st[0] = nloc; b.st[1] = nx; }
        const unsigned old = xb_add(&bar[XB_XSUB(b.x)], 1u);
        const unsigned gen = old / nloc;
        if (old + 1u == (gen + 1u) * nloc) {
            __builtin_amdgcn_fence(__ATOMIC_RELEASE, "agent");
            asm volatile("s_waitcnt vmcnt(0)" ::: "memory");
            const unsigned og = xb_add(&bar[XB_TOP], 1u);
            const unsigned tg = og / nx;
            if (og + 1u == (tg + 1u) * nx) xb_add(&bar[XB_TOPGEN], 1u);
            else XB_SPIN(xb_ld(&bar[XB_TOPGEN]) == tg, bar);
            __builtin_amdgcn_fence(__ATOMIC_ACQUIRE, "agent");
            xb_add(&bar[XB_XGEN(b.x)], 1u);
            asm volatile("s_waitcnt vmcnt(0)" ::: "memory");
        } else {
            XB_SPIN(xb_ld(&bar[XB_XGEN(b.x)]) == gen, bar);
            __builtin_amdgcn_fence(__ATOMIC_ACQUIRE, "agent");
            asm volatile("s_waitcnt vmcnt(0)" ::: "memory");
        }
    }
    __syncthreads();
}

__global__ void __launch_bounds__(512, 2) mega_fwd(Params Pk) {
    extern __shared__ __attribute__((aligned(16))) unsigned char lds_raw[];
    LAS unsigned char* lds = (LAS unsigned char*)lds_raw;
    cg::grid_group grid = cg::this_grid();
    int ph = 0;
    if (threadIdx.x < 4) ((LAS unsigned*)(lds + 131072))[threadIdx.x] = 0u;
    __syncthreads();
    XcdBarrier xbar = xcd_barrier_post((unsigned*)(Pk.ws + WS_BAR), (volatile LAS unsigned*)(lds + 131072));
#ifndef PROBE_PH
#define PROBE_PH -1
#endif
#define RUN(k) ((k) >= Pk.ph_lo && (k) < Pk.ph_hi)
#define SEAM(k) do { if ((k) + 1 < Pk.ph_hi) xcd_barrier(xbar); } while (0)
#define REPS(k) (((k) == PROBE_PH) ? 2 : 1)
    if (RUN(ph)) { for (int rp = 0; rp < REPS(0); ++rp) { phase0(lds); if (ph + 1 < Pk.ph_hi) grid.sync(); } } ++ph;
#pragma unroll 1
    for (int l = 0; l < NLAYER; ++l) {
        if (RUN(ph)) for (int rp = 0; rp < REPS(1 + (l == 0 ? 0 : 100)); ++rp) {
            const CAS Params& P = kparams(); unsigned char* ws = P.ws;
            { pg8::Gemm g{(const bf16_t*)(ws + WS_XB), (const bf16_t*)(ws + WS_WIN) + (size_t)l * NIN * DM, NPR, NIN, DM};
              pg8::StaticOrder S; S.init(NPR, NIN, gridDim.x, blockIdx.x);
              pg8::EpiBf16 E{(bf16_t*)(ws + WS_Z), NIN};
              pg8::gemm_phase(lds, g, S, E); }
            { pg8::Gemm g{(const bf16_t*)(ws + WS_PB) + (size_t)l * MT * DPLE, (const bf16_t*)(ws + WS_WP) + (size_t)l * DM * DPLE, NPR, DM, DPLE};
              pg8::StaticOrder S; S.init(NPR, DM, gridDim.x, blockIdx.x);
              pg8::EpiBf16 E{(bf16_t*)(ws + WS_E), DM};
              pg8::gemm_phase(lds, g, S, E); }
            SEAM(ph);
        } ++ph;
        if (RUN(ph)) for (int rp = 0; rp < REPS(2 + (l == 0 ? 0 : 100)); ++rp) { phase2a(l, lds); SEAM(ph); } ++ph;
        if (RUN(ph)) for (int rp = 0; rp < REPS(3 + (l == 0 ? 0 : 100)); ++rp) { phase2c(l, lds); SEAM(ph); } ++ph;
        if (RUN(ph)) for (int rp = 0; rp < REPS(4 + (l == 0 ? 0 : 100)); ++rp) {
            const CAS Params& P = kparams(); unsigned char* ws = P.ws;
            pg8::Gemm g{(const bf16_t*)(ws + WS_YMIX), (const bf16_t*)(ws + WS_WOUT) + (size_t)l * DM * DM, NPR, DM, DM};
            pg8::StaticOrder S; S.init(NPR, DM, gridDim.x, blockIdx.x);
            pg8::EpiRes E{(const bf16_t*)(ws + WS_XB), (bf16_t*)(ws + WS_RB)};
            pg8::gemm_phase(lds, g, S, E);
            SEAM(ph);
        } ++ph;
        if (RUN(ph)) for (int rp = 0; rp < REPS(5 + (l == 0 ? 0 : 100)); ++rp) {
            const CAS Params& P = kparams(); unsigned char* ws = P.ws;
            pg8::Gemm g{(const bf16_t*)(ws + WS_RB), (const bf16_t*)(ws + WS_WG) + (size_t)l * DM * DM, NPR, DM, DM};
            pg8::StaticOrder S; S.init(NPR, DM, gridDim.x, blockIdx.x);
            pg8::EpiGate E{(const bf16_t*)(ws + WS_RB), (const bf16_t*)(ws + WS_E), P.in[21] + l * DM, (bf16_t*)(ws + WS_YMIX)};
            pg8::gemm_phase(lds, g, S, E);
            SEAM(ph);
        } ++ph;
        if (RUN(ph)) { phase4(l); SEAM(ph); } ++ph;
    }
}
constexpr int N_PHASES = 1 + 6 * NLAYER;
constexpr int LDS_BYTES = 131072 + 16;

extern "C" void kernel_launch(void* const* d_in, const int* in_sizes, int n_in, void* d_out, int out_size, void* d_ws, size_t ws_size, hipStream_t stream) {
    static int grid = 0;
    if (grid == 0) {
        if (n_in != 24 || ws_size < WS_END) { fprintf(stderr, "kernel_launch: need 24 inputs and >= %zu bytes of workspace (got %d, %zu)\n", (size_t)WS_END, n_in, ws_size); grid = -1; return; }
        int dev = 0, cus = 0, per_cu = 0;
        hipGetDevice(&dev); hipDeviceGetAttribute(&cus, hipDeviceAttributeMultiprocessorCount, dev);
        if (hipFuncSetAttribute((const void*)mega_fwd, hipFuncAttributeMaxDynamicSharedMemorySize, LDS_BYTES) != hipSuccess) { fprintf(stderr, "kernel_launch: hipFuncSetAttribute failed\n"); grid = -1; return; }
        if (hipOccupancyMaxActiveBlocksPerMultiprocessor(&per_cu, (const void*)mega_fwd, 512, LDS_BYTES) != hipSuccess || per_cu < 1) { fprintf(stderr, "kernel_launch: occupancy query failed (%d)\n", per_cu); grid = -1; return; }
        grid = cus * per_cu;
        fprintf(stderr, "kernel_launch: grid %d (%d CUs x %d)\n", grid, cus, per_cu);
    }
    if (grid < 0) return;
    if (hipMemsetAsync((char*)d_ws + WS_BAR, 0, XCD_BAR_WORDS * 4, stream) != hipSuccess) { fprintf(stderr, "kernel_launch: memset failed\n"); return; }
    Params p{};
    for (int i = 0; i < 24; ++i) p.in[i] = (const float*)d_in[i];
    p.out = (float*)d_out; p.ws = (unsigned char*)d_ws; p.ph_lo = 0; p.ph_hi = N_PHASES;
    void* args[] = {&p};
    hipError_t e = hipLaunchCooperativeKernel((const void*)mega_fwd, dim3(grid), dim3(512), args, LDS_BYTES, stream);
    if (e != hipSuccess) fprintf(stderr, "kernel_launch: cooperative launch failed: %s (grid %d)\n", hipGetErrorString(e), grid);
}
```

```cpp
#define PROBE_PH 5
#include <hip/hip_runtime.h>
#include <hip/hip_cooperative_groups.h>
#include <cstdio>
namespace cg = cooperative_groups;

#define LAS __attribute__((address_space(3)))
typedef unsigned short bf16_t;
typedef short bf16x8 __attribute__((ext_vector_type(8)));
typedef float f32x4 __attribute__((ext_vector_type(4)));
typedef unsigned u32x4 __attribute__((ext_vector_type(4)));
typedef unsigned u32x2 __attribute__((ext_vector_type(2)));

constexpr int DM = 2048, NPR = 8192, NSR = 512, MT = 8704, NLAYER = 2, DL = 1024, NIN = 6144, DPLE = 256, SEQ = 2048, NB = 4, DB = 128;
constexpr float ALPHA = 1.4142135623730951f;
constexpr size_t O_Y = 0, O_LH_P = (size_t)MT * DM, O_LC_P = O_LH_P + 2 * 4 * 1024, O_SC_P = O_LC_P + 2 * 4 * 3 * 1024,
                 O_LH_S = O_SC_P + 2 * 4 * 2 * 1024, O_LC_S = O_LH_S + 2 * 128 * 1024, O_SC_S = O_LC_S + 2 * 128 * 3 * 1024;
constexpr size_t SZ_ACT = (size_t)MT * DM * 2;
constexpr size_t WS_XB = 0, WS_PB = WS_XB + SZ_ACT, WS_WIN = WS_PB + (size_t)2 * MT * 256 * 2, WS_WOUT = WS_WIN + (size_t)2 * NIN * DM * 2,
                 WS_WG = WS_WOUT + (size_t)2 * DM * DM * 2, WS_WP = WS_WG + (size_t)2 * DM * DM * 2, WS_WA = WS_WP + (size_t)2 * DM * 256 * 2,
                 WS_WX = WS_WA + 524288, WS_SUM = WS_WX + 524288, WS_Z = WS_SUM + 1048576, WS_HL = WS_Z + (size_t)MT * NIN * 2,
                 WS_PP = WS_HL + SZ_ACT, WS_YMIX = WS_PP + SZ_ACT, WS_E = WS_YMIX + SZ_ACT, WS_BAR = WS_E + SZ_ACT, WS_END = WS_BAR + 16384;
constexpr size_t WS_RB = WS_HL;

struct Params { const float* in[24]; float* out; unsigned char* ws; int ph_lo, ph_hi; };
#define CAS __attribute__((address_space(4)))
__device__ __forceinline__ const CAS Params& kparams() { const CAS Params* p = (const CAS Params*)__builtin_amdgcn_kernarg_segment_ptr(); asm volatile("" : "+s"(p)); return *p; }

__device__ __forceinline__ unsigned cvt_pk_bf16(float lo, float hi) { unsigned r; asm volatile("v_cvt_pk_bf16_f32 %0, %1, %2" : "=v"(r) : "v"(lo), "v"(hi)); return r; }
__device__ __forceinline__ float bf_lo(unsigned w) { return __uint_as_float(w << 16); }
__device__ __forceinline__ float bf_hi(unsigned w) { return __uint_as_float(w & 0xffff0000u); }
__device__ __forceinline__ float sigmoidf_(float x) { return __builtin_amdgcn_rcpf(1.0f + __expf(-x)); }
__device__ __forceinline__ u32x4 pack8(const f32x4 a, const f32x4 b) { u32x4 w; w.x = cvt_pk_bf16(a[0], a[1]); w.y = cvt_pk_bf16(a[2], a[3]); w.z = cvt_pk_bf16(b[0], b[1]); w.w = cvt_pk_bf16(b[2], b[3]); return w; }
__device__ __forceinline__ void unpack8_(const u32x4 q, f32x4& lo, f32x4& hi) { lo = (f32x4){bf_lo(q[0]), bf_hi(q[0]), bf_lo(q[1]), bf_hi(q[1])}; hi = (f32x4){bf_lo(q[2]), bf_hi(q[2]), bf_lo(q[3]), bf_hi(q[3])}; }
#define UNPACK8(q_, lo_, hi_) unpack8_(q_, lo_, hi_)

namespace pg8 {
constexpr int BM = 256, BK = 64, HALF = 128, HTB = HALF * BK * 2, STAGE_BYTES = 8 * HTB, NXCD = 8, WGM = 8;
__host__ __device__ __forceinline__ int lds_byte(int r, int c) { const int st = (r >> 4) * 2 + (c >> 5), rr = r & 15, cc = c & 31, ob = rr * 64 + cc * 2; return st * 1024 + (ob ^ (((ob >> 9) & 1) << 5)); }
__host__ __device__ __forceinline__ void stage_rc(int b, int& R, int& C) { const int st = b / 1024, sb = b % 1024, swz = sb ^ (((sb >> 9) & 1) << 5); R = (st >> 1) * 16 + swz / 64; C = (st & 1) * 32 + (swz % 64) / 2; }
__host__ __device__ __forceinline__ int perm32(int rho) { const int n = rho >> 4, i = rho & 15; return 8 * (i >> 2) + 4 * n + (i & 3); }
struct Unit { int pm, pn; };
struct Gemm { const bf16_t* A; const bf16_t* Bt; int M, N, K; };
struct StaticOrder {
    int nM, nN, nwg, G, c;
    __device__ void init(int M, int N, int G_, int c_) { nM = M / BM; nN = N / BM; nwg = nM * nN; G = G_; c = c_; }
    __device__ bool next(int i, Unit& u) const {
        const long L = (long)i * G + c; if (L >= nwg || c < 0) return false;
        int wgid = (int)L; { const int q = nwg / NXCD, r = nwg % NXCD, xcd = wgid % NXCD, off = wgid / NXCD; wgid = (xcd < r ? xcd * (q + 1) : r * (q + 1) + (xcd - r) * q) + off; }
        const int nig = WGM * nN, gid = wgid / nig, fm = gid * WGM, gsz = (nM - fm) < WGM ? (nM - fm) : WGM;
        u.pm = fm + ((wgid % nig) % gsz); u.pn = (wgid % nig) / gsz; return true;
    }
};
struct EpiBf16 {
    bf16_t* O; int ldc;
    __device__ __forceinline__ void emit(int row, int col, const f32x4 v0, const f32x4 v1) const { *(u32x4*)(O + (size_t)row * ldc + col) = pack8(v0, v1); }
};
struct EpiRes {
    const bf16_t* xb; bf16_t* rb;
    __device__ __forceinline__ void emit(int row, int col, const f32x4 v0, const f32x4 v1) const {
        const size_t off = (size_t)row * DM + col; const u32x4 xw = *(const u32x4*)(xb + off); f32x4 x0, x1; UNPACK8(xw, x0, x1);
        *(u32x4*)(rb + off) = pack8(v0 + ALPHA * x0, v1 + ALPHA * x1); }
};
struct EpiGate {
    const bf16_t* rb; const bf16_t* e; const float* bg; bf16_t* tb;
    __device__ __forceinline__ void emit(int row, int col, const f32x4 v0, const f32x4 v1) const {
        const size_t off = (size_t)row * DM + col;
        const u32x4 rw = *(const u32x4*)(rb + off), ew = *(const u32x4*)(e + off); f32x4 r0, r1, e0, e1; UNPACK8(rw, r0, r1); UNPACK8(ew, e0, e1);
        f32x4 g0 = v0 + *(const f32x4*)(bg + col), g1 = v1 + *(const f32x4*)(bg + col + 4);
#pragma unroll
        for (int j = 0; j < 4; ++j) { g0[j] = sigmoidf_(g0[j]); g1[j] = sigmoidf_(g1[j]); }
        *(u32x4*)(tb + off) = pack8(r0 + g0 * e0, r1 + g1 * e1); }
};

template <class Epi, class Sched>
__device__ __forceinline__ void gemm_phase(LAS unsigned char* lds, const Gemm g, const Sched& S, const Epi& E) {
    int tid_ = threadIdx.x; asm volatile("" : "+v"(tid_));
    const int tid = tid_, wid = __builtin_amdgcn_readfirstlane(tid >> 6), lane = tid & 63, wr = wid >> 2, wc = wid & 3, fr = lane & 15, fq = lane >> 4;
    const int K = g.K, nt = K / BK;
    unsigned voffA, voffB;
    { int R, C; stage_rc(tid * 16, R, C); const int Rb = (R & ~31) + perm32(R & 31); voffA = (unsigned)(R * K + C) * 2u; voffB = (unsigned)(Rb * K + C) * 2u; }
    const size_t qstep = (size_t)64 * K * 2;
    const size_t kstep = (size_t)(BK * 2);
    const size_t hstep = (size_t)HALF * K * 2;
    const size_t tstep = 2 * hstep;
    const unsigned ldsw = (unsigned)wid * 1024u;
    const int aoff = lds_byte(wr * 64 + fr, fq * 8), boff = lds_byte(wc * 32 + fr, fq * 8);
    const unsigned xoff = (unsigned)(fr * K + fq * 8) * 2u;
#define PG8_SA(b, h) (((b) * 2 + (h)) * HTB)
#define PG8_SB(b, h) ((4 + (b) * 2 + (h)) * HTB)
#define PG8_STAGE(bufoff, gbase, voff) do { _Pragma("unroll") for (int _i = 0; _i < 2; ++_i) \
        __builtin_amdgcn_global_load_lds((const unsigned*)((const char*)(gbase) + _i * qstep + (voff)), (LAS unsigned*)(lds + (bufoff) + ldsw + _i * 8192), 16, 0, 0); } while (0)
#define PG8_LDA(dst, b, h) do { _Pragma("unroll") for (int m = 0; m < 4; ++m) _Pragma("unroll") for (int k = 0; k < 2; ++k) dst[m][k] = *(const LAS bf16x8*)(lds + PG8_SA(b, h) + aoff + m * 2048 + k * 1024); } while (0)
#define PG8_LDB(dst, b, h) do { _Pragma("unroll") for (int n = 0; n < 2; ++n) _Pragma("unroll") for (int k = 0; k < 2; ++k) dst[n][k] = *(const LAS bf16x8*)(lds + PG8_SB(b, h) + boff + n * 2048 + k * 1024); } while (0)
#define PG8_MMA(ai, bj, At, Bt) do { __builtin_amdgcn_s_setprio(1); _Pragma("unroll") for (int m = 0; m < 4; ++m) _Pragma("unroll") for (int n = 0; n < 2; ++n) _Pragma("unroll") for (int k = 0; k < 2; ++k) \
        acc[ai][bj][m][n] = __builtin_amdgcn_mfma_f32_16x16x32_bf16(Bt[n][k], At[m][k], acc[ai][bj][m][n], 0, 0, 0); __builtin_amdgcn_s_setprio(0); } while (0)
#define PG8_LDX(kt) do { const char* _x = cX + (size_t)(kt) * kstep; \
        asm volatile("global_load_dwordx4 %0, %2, %3\n\tglobal_load_dwordx4 %1, %2, %3 offset:64" : "=&v"(ax[0]), "=&v"(ax[1]) : "v"(xoff), "s"(_x) : "memory"); } while (0)
#define PG8_XREADY() asm volatile("" : "+v"(ax[0]), "+v"(ax[1]))
#define PG8_XMMA() do { if (wr == 0) { _Pragma("unroll") for (int n = 0; n < 2; ++n) _Pragma("unroll") for (int k = 0; k < 2; ++k) accx[n] = __builtin_amdgcn_mfma_f32_16x16x32_bf16(B0[n][k], ax[k], accx[n], 0, 0, 0); } \
        else { _Pragma("unroll") for (int n = 0; n < 2; ++n) _Pragma("unroll") for (int k = 0; k < 2; ++k) accx[n] = __builtin_amdgcn_mfma_f32_16x16x32_bf16(B1[n][k], ax[k], accx[n], 0, 0, 0); } } while (0)
#define PG8_WAIT_V(n) asm volatile("s_waitcnt vmcnt(" #n ")" ::: "memory")
#define PG8_WAIT_L(n) asm volatile("s_waitcnt lgkmcnt(" #n ")" ::: "memory")
#define PG8_BAR __builtin_amdgcn_s_barrier()
#define PG8_SCHED __builtin_amdgcn_sched_barrier(0)
    Unit cur, nxt; int ui = 0;
    if (!S.next(0, cur)) return;
    f32x4 acc[2][2][4][2], accx[2];
#pragma unroll
    for (int a = 0; a < 2; ++a)
#pragma unroll
        for (int b = 0; b < 2; ++b)
#pragma unroll
            for (int m = 0; m < 4; ++m)
#pragma unroll
                for (int n = 0; n < 2; ++n) acc[a][b][m][n] = (f32x4){0.f, 0.f, 0.f, 0.f};
    accx[0] = (f32x4){0.f, 0.f, 0.f, 0.f}; accx[1] = accx[0];
    bf16x8 At[4][2], B0[2][2], B1[2][2], ax[2];
    const char* cA = (const char*)g.A + (size_t)cur.pm * tstep; const char* cB = (const char*)g.Bt + (size_t)cur.pn * tstep;
    const char* cX = (const char*)g.A + ((size_t)NPR + 16 * cur.pm) * K * 2;
    PG8_STAGE(PG8_SB(0, 0), cB, voffB); PG8_STAGE(PG8_SA(0, 0), cA, voffA); PG8_STAGE(PG8_SB(0, 1), cB + hstep, voffB); PG8_STAGE(PG8_SA(0, 1), cA + hstep, voffA);
    if (wr == 1) PG8_BAR;
    PG8_WAIT_V(4); PG8_BAR;
    PG8_STAGE(PG8_SB(1, 0), cB + kstep, voffB); PG8_STAGE(PG8_SA(1, 0), cA + kstep, voffA); PG8_STAGE(PG8_SB(1, 1), cB + hstep + kstep, voffB);
    PG8_WAIT_V(6); PG8_BAR;
    for (;;) {
        const bool has_next = S.next(ui + 1, nxt);
        const char* nA = has_next ? (const char*)g.A + (size_t)nxt.pm * tstep : cA; const char* nB = has_next ? (const char*)g.Bt + (size_t)nxt.pn * tstep : cB;
        for (int t = 0; t < nt; t += 2) {
            const bool last = (t == nt - 2);
            const char* a1 = cA + (size_t)(t + 1) * kstep;
            const char* a2 = last ? nA : cA + (size_t)(t + 2) * kstep; const char* b2 = last ? nB : cB + (size_t)(t + 2) * kstep;
            const char* a3 = a2 + kstep; const char* b3 = b2 + kstep;
            PG8_LDB(B0, 0, 0); PG8_SCHED; PG8_LDA(At, 0, 0); PG8_STAGE(PG8_SA(1, 1), a1 + hstep, voffA); PG8_LDX(t);
            PG8_WAIT_L(8); PG8_BAR; PG8_WAIT_L(0); PG8_MMA(0, 0, At, B0); PG8_BAR; PG8_SCHED;
            PG8_LDB(B1, 0, 1); PG8_STAGE(PG8_SB(0, 0), b2, voffB);
            PG8_BAR; PG8_WAIT_L(0); PG8_MMA(0, 1, At, B1); PG8_BAR;
            PG8_LDA(At, 0, 1); PG8_STAGE(PG8_SA(0, 0), a2, voffA);
            PG8_BAR; PG8_WAIT_L(0); PG8_MMA(1, 0, At, B0); PG8_BAR; PG8_SCHED;
            PG8_STAGE(PG8_SB(0, 1), b2 + hstep, voffB);
            PG8_WAIT_V(6); PG8_XREADY(); PG8_BAR; PG8_MMA(1, 1, At, B1); PG8_XMMA(); PG8_BAR; PG8_SCHED;
            PG8_LDB(B0, 1, 0); PG8_SCHED; PG8_LDA(At, 1, 0); PG8_STAGE(PG8_SA(0, 1), a2 + hstep, voffA); PG8_LDX(t + 1);
            PG8_WAIT_L(8); PG8_BAR; PG8_WAIT_L(0); PG8_MMA(0, 0, At, B0); PG8_BAR; PG8_SCHED;
            PG8_LDB(B1, 1, 1); PG8_STAGE(PG8_SB(1, 0), b3, voffB);
            PG8_BAR; PG8_WAIT_L(0); PG8_MMA(0, 1, At, B1); PG8_BAR;
            PG8_LDA(At, 1, 1); PG8_STAGE(PG8_SA(1, 0), a3, voffA);
            PG8_BAR; PG8_WAIT_L(0); PG8_MMA(1, 0, At, B0); PG8_BAR; PG8_SCHED;
            PG8_STAGE(PG8_SB(1, 1), b3 + hstep, voffB);
            PG8_WAIT_V(6); PG8_XREADY(); PG8_BAR; PG8_MMA(1, 1, At, B1); PG8_XMMA(); PG8_BAR; PG8_SCHED;
        }
        {
            const int row0 = cur.pm * BM + wr * 64 + fr, col0 = cur.pn * BM + wc * 32 + 8 * fq;
#pragma unroll
            for (int ai = 0; ai < 2; ++ai)
#pragma unroll
                for (int m = 0; m < 4; ++m) {
#pragma unroll
                    for (int bj = 0; bj < 2; ++bj) E.emit(row0 + ai * HALF + m * 16, col0 + bj * HALF, acc[ai][bj][m][0], acc[ai][bj][m][1]);
                    if (m == 3) asm volatile("" ::: "memory"); }
            E.emit(NPR + 16 * cur.pm + fr, col0 + wr * HALF, accx[0], accx[1]);
        }
        if (!has_next) break;
#pragma unroll
        for (int a = 0; a < 2; ++a)
#pragma unroll
            for (int b = 0; b < 2; ++b)
#pragma unroll
                for (int m = 0; m < 4; ++m)
#pragma unroll
                    for (int n = 0; n < 2; ++n) acc[a][b][m][n] = (f32x4){0.f, 0.f, 0.f, 0.f};
        accx[0] = (f32x4){0.f, 0.f, 0.f, 0.f}; accx[1] = accx[0];
        cur = nxt; cA = nA; cB = nB; ++ui;
        cX = (const char*)g.A + ((size_t)NPR + 16 * cur.pm) * K * 2;
    }
    PG8_WAIT_V(0);
    if (wr == 0) PG8_BAR;
    PG8_BAR;
#undef PG8_SA
#undef PG8_SB
#undef PG8_STAGE
#undef PG8_LDA
#undef PG8_LDB
#undef PG8_MMA
#undef PG8_LDX
#undef PG8_XMMA
#undef PG8_XREADY
#undef PG8_WAIT_V
#undef PG8_WAIT_L
#undef PG8_BAR
#undef PG8_SCHED
}
}

__device__ __forceinline__ void cvt_rows(const float* __restrict__ srcA, size_t nA8, const float* __restrict__ srcB, size_t nB8, bf16_t* __restrict__ dst) {
    const size_t n8 = nA8 + nB8;
    for (size_t i = (size_t)blockIdx.x * 512 + threadIdx.x; i < n8; i += (size_t)gridDim.x * 512) {
        const float* s = (i < nA8) ? srcA + i * 8 : srcB + (i - nA8) * 8;
        const f32x4 a = *(const f32x4*)s, b = *(const f32x4*)(s + 4);
        *(u32x4*)(dst + i * 8) = pack8(a, b);
    }
}
__device__ __forceinline__ void tr_tile(const float* __restrict__ src, bf16_t* __restrict__ dst, int R, int C, int idx, LAS float* tile) {
    int tid_ = threadIdx.x; asm volatile("" : "+v"(tid_));
    const int tid = tid_, ntc = C >> 6, tr = idx / ntc, tc = idx - tr * ntc;
#pragma unroll
    for (int i = 0; i < 2; ++i) { const int e = tid + 512 * i, row = e >> 4, c4 = e & 15;
        const f32x4 v = *(const f32x4*)(src + (size_t)(tr * 64 + row) * C + tc * 64 + c4 * 4);
#pragma unroll
        for (int j = 0; j < 4; ++j) tile[row * 65 + c4 * 4 + j] = v[j]; }
    __syncthreads();
    { const int cc = tid >> 3, r0 = (tid & 7) * 8; f32x4 a, b;
#pragma unroll
      for (int j = 0; j < 4; ++j) { a[j] = tile[(r0 + j) * 65 + cc]; b[j] = tile[(r0 + 4 + j) * 65 + cc]; }
      *(u32x4*)(dst + (size_t)(tc * 64 + cc) * R + tr * 64 + r0) = pack8(a, b); }
    __syncthreads();
}
__device__ __forceinline__ void tr_tile_wide(const float* __restrict__ src, bf16_t* __restrict__ dst, int R, int C, int idx, LAS float* tile) {
    int tid_ = threadIdx.x; asm volatile("" : "+v"(tid_));
    const int tid = tid_, ntc = C >> 8, tr = idx / ntc, tc = idx - tr * ntc;
    f32x4 v[8];
#pragma unroll
    for (int i = 0; i < 8; ++i) { const int e = tid + 512 * i, c4 = e & 15, row = (e >> 4) & 63, sub = e >> 10;
        v[i] = *(const f32x4*)(src + (size_t)(tr * 64 + row) * C + tc * 256 + sub * 64 + c4 * 4); }
#pragma unroll
    for (int i = 0; i < 8; ++i) { const int e = tid + 512 * i, c4 = e & 15, row = (e >> 4) & 63, sub = e >> 10;
#pragma unroll
        for (int j = 0; j < 4; ++j) tile[row * 257 + sub * 64 + c4 * 4 + j] = v[i][j]; }
    __syncthreads();
#pragma unroll
    for (int i = 0; i < 4; ++i) { const int item = tid + 512 * i, cc = item >> 3, r0 = (item & 7) * 8; f32x4 a, b;
#pragma unroll
        for (int j = 0; j < 4; ++j) { a[j] = tile[(r0 + j) * 257 + cc]; b[j] = tile[(r0 + 4 + j) * 257 + cc]; }
        *(u32x4*)(dst + (size_t)(tc * 256 + cc) * R + tr * 64 + r0) = pack8(a, b); }
    __syncthreads();
}
__device__ __forceinline__ void phase0(LAS unsigned char* lds) {
    const CAS Params& P = kparams();
    unsigned char* ws = P.ws;
    LAS float* tile = (LAS float*)lds;
    constexpr int T_IN = 32 * 24, T_SQ = 32 * 8, T_WP = 4 * 8, T_HD = 4;
    constexpr int E0 = 2 * T_IN, E1 = E0 + 2 * T_SQ, E2 = E1 + 2 * T_SQ, E3 = E2 + 2 * T_WP, E4 = E3 + 16 * T_HD, E5 = E4 + 16 * T_HD;
    for (int T = blockIdx.x; T < E5; T += gridDim.x) {
        if (T < E0) { const int l = T / T_IN, i = T - l * T_IN; tr_tile_wide(P.in[7] + (size_t)l * DM * NIN, (bf16_t*)(ws + WS_WIN) + (size_t)l * NIN * DM, DM, NIN, i, tile); }
        else if (T < E1) { const int t = T - E0, l = t / T_SQ, i = t - l * T_SQ; tr_tile_wide(P.in[18] + (size_t)l * DM * DM, (bf16_t*)(ws + WS_WOUT) + (size_t)l * DM * DM, DM, DM, i, tile); }
        else if (T < E2) { const int t = T - E1, l = t / T_SQ, i = t - l * T_SQ; tr_tile_wide(P.in[20] + (size_t)l * DM * DM, (bf16_t*)(ws + WS_WG) + (size_t)l * DM * DM, DM, DM, i, tile); }
        else if (T < E3) { const int t = T - E2, l = t / T_WP, i = t - l * T_WP; tr_tile_wide(P.in[19] + (size_t)l * DPLE * DM, (bf16_t*)(ws + WS_WP) + (size_t)l * DM * DPLE, DPLE, DM, i, tile); }
        else if (T < E4) { const int t = T - E3, mtx = t >> 2, i = t & 3; tr_tile(P.in[10] + (size_t)mtx * 16384, (bf16_t*)(ws + WS_WA) + (size_t)mtx * 16384, 128, 128, i, tile); }
        else { const int t = T - E4, mtx = t >> 2, i = t & 3; tr_tile(P.in[12] + (size_t)mtx * 16384, (bf16_t*)(ws + WS_WX) + (size_t)mtx * 16384, 128, 128, i, tile); }
    }
    cvt_rows(P.in[0], (size_t)NPR * DM / 8, P.in[1], (size_t)NSR * DM / 8, (bf16_t*)(ws + WS_XB));
    for (int l = 0; l < NLAYER; ++l)
        cvt_rows(P.in[5] + (size_t)l * NPR * DPLE, (size_t)NPR * DPLE / 8, P.in[6] + (size_t)l * NSR * DPLE, (size_t)NSR * DPLE / 8, (bf16_t*)(ws + WS_PB) + (size_t)l * MT * DPLE);
}

constexpr int N_LRU_TILES = 4 * 32 * 8 + 8 * 8;
__device__ __forceinline__ void phase2a(int l, LAS unsigned char* lds) {
    const CAS Params& P = kparams();
    int tid_ = threadIdx.x; asm volatile("" : "+v"(tid_));
    const int tid = tid_, lane = tid & 63, wid = tid >> 6, fr = lane & 15, fq = lane >> 4;
    LAS bf16_t* xcA = (LAS bf16_t*)lds;
    LAS float* xcF = (LAS float*)(lds + 17408);
    LAS float* aL = (LAS float*)(lds + 17408 + 33792);
    LAS float* uL = aL + 64 * 128;
    LAS float* subA = uL + 64 * 128;
    LAS float* subH = subA + 512;
    const bf16_t* z = (const bf16_t*)(P.ws + WS_Z);
    float* hlb = (float*)(P.ws + WS_HL); float* ppb = (float*)(P.ws + WS_PP); float* summ = (float*)(P.ws + WS_SUM);
    const float* cw = P.in[8] + (size_t)l * 4 * DL; const float* cb = P.in[9] + (size_t)l * DL;
    for (int tile = blockIdx.x; tile < N_LRU_TILES; tile += gridDim.x) {
        const bool smp = tile >= 1024;
        int b = 0, hd, c;
        if (!smp) { hd = tile & 7; c = (tile >> 3) & 31; b = tile >> 8; } else { const int s = tile - 1024; hd = s & 7; c = s >> 3; }
        const int row0 = smp ? NPR + c * 64 : b * SEQ + c * 64;
        {
            const int g = tid & 15, chl = g * 8, ch0 = hd * 128 + chl;
            f32x4 w[4][2], bias[2];
#pragma unroll
            for (int k = 0; k < 4; ++k) { w[k][0] = *(const f32x4*)(cw + k * DL + ch0); w[k][1] = *(const f32x4*)(cw + k * DL + ch0 + 4); }
            bias[0] = *(const f32x4*)(cb + ch0); bias[1] = *(const f32x4*)(cb + ch0 + 4);
#pragma unroll
            for (int it = 0; it < 2; ++it) {
                const int r = (tid >> 4) + it * 32;
                f32x4 a0 = bias[0], a1 = bias[1];
#pragma unroll
                for (int k = 0; k < 4; ++k) {
                    f32x4 x0, x1; bool have = true, fromz = true; int tt;
                    if (!smp) { tt = c * 64 + r - k; have = tt >= 0; } else { tt = (r & 3) - k; fromz = tt >= 0; }
                    if (!have) { x0 = (f32x4){0.f, 0.f, 0.f, 0.f}; x1 = x0; }
                    else if (fromz) { const u32x4 v = *(const u32x4*)(z + (size_t)(row0 + r - k) * NIN + ch0); UNPACK8(v, x0, x1); }
                    else { const int sq = c * 16 + (r >> 2); const float* sp = P.in[3] + ((size_t)(l * DB + sq) * 3 + (3 + tt)) * DL + ch0; x0 = *(const f32x4*)sp; x1 = *(const f32x4*)(sp + 4); }
                    a0 += w[3 - k][0] * x0; a1 += w[3 - k][1] * x1;
                    if (k == 0) {
                        if (!smp) { if (c == 31 && r >= 61) { float* o = P.out + O_LC_P + ((size_t)(l * NB + b) * 3 + (r - 61)) * DL + ch0; *(f32x4*)o = x0; *(f32x4*)(o + 4) = x1; } }
                        else if ((r & 3) >= 1) { const int sq = c * 16 + (r >> 2); float* o = P.out + O_LC_S + ((size_t)(l * DB + sq) * 3 + ((r & 3) - 1)) * DL + ch0; *(f32x4*)o = x0; *(f32x4*)(o + 4) = x1; }
                    }
                }
                *(LAS f32x4*)(xcF + r * 132 + chl) = a0; *(LAS f32x4*)(xcF + r * 132 + chl + 4) = a1;
                *(LAS u32x4*)(xcA + r * 136 + chl) = pack8(a0, a1);
            }
        }
        __syncthreads();
        {
            const int n0 = wid * 16, chl = n0 + fr, chg = hd * 128 + chl;
            const bf16_t* waT = (const bf16_t*)(P.ws + WS_WA) + ((size_t)((l * 8 + hd) * 128 + chl)) * 128 + fq * 8;
            const bf16_t* wxT = (const bf16_t*)(P.ws + WS_WX) + ((size_t)((l * 8 + hd) * 128 + chl)) * 128 + fq * 8;
            bf16x8 fa[4], fx[4];
#pragma unroll
            for (int kk = 0; kk < 4; ++kk) { fa[kk] = *(const bf16x8*)(waT + kk * 32); fx[kk] = *(const bf16x8*)(wxT + kk * 32); }
            f32x4 accR[4], accI[4];
#pragma unroll
            for (int m = 0; m < 4; ++m) { accR[m] = (f32x4){0.f, 0.f, 0.f, 0.f}; accI[m] = accR[m]; }
#pragma unroll
            for (int m = 0; m < 4; ++m)
#pragma unroll
                for (int kk = 0; kk < 4; ++kk) {
                    const bf16x8 a = *(const LAS bf16x8*)(xcA + (m * 16 + fr) * 136 + kk * 32 + fq * 8);
                    accR[m] = __builtin_amdgcn_mfma_f32_16x16x32_bf16(a, fa[kk], accR[m], 0, 0, 0);
                    accI[m] = __builtin_amdgcn_mfma_f32_16x16x32_bf16(a, fx[kk], accI[m], 0, 0, 0);
                }
            const float ba = P.in[11][l * DL + chg], bx = P.in[13][l * DL + chg], lam = P.in[14][l * DL + chg];
            const float sp = log1pf(expf(-lam));
#pragma unroll
            for (int m = 0; m < 4; ++m)
#pragma unroll
                for (int j = 0; j < 4; ++j) {
                    const int row = m * 16 + fq * 4 + j;
                    const float rr = sigmoidf_(accR[m][j] + ba), ii = sigmoidf_(accI[m][j] + bx);
                    const float la = -8.0f * rr * sp, a = __expf(la), x2 = 2.0f * la;
                    const float ser = -x2 * (1.0f + x2 * (0.5f + x2 * (0.16666667f + x2 * 0.041666668f)));
                    const float om = (x2 > -0.125f) ? ser : (1.0f - a) * (1.0f + a);
                    const float mult = __builtin_amdgcn_sqrtf(fmaxf(om, 0.0f));
                    aL[row * 128 + chl] = a; uL[row * 128 + chl] = mult * ii * xcF[row * 132 + chl];
                }
        }
        __syncthreads();
        {
            const int ch = tid & 127, sub = tid >> 7, chg = hd * 128 + ch;
            if (!smp) {
                float h = 0.f, pr = 1.f;
#pragma unroll 4
                for (int s = 0; s < 16; ++s) { const int t = sub * 16 + s; const float a = aL[t * 128 + ch], u = uL[t * 128 + ch]; h = a * h + u; pr *= a; uL[t * 128 + ch] = h; aL[t * 128 + ch] = pr; }
                subA[sub * 128 + ch] = pr; subH[sub * 128 + ch] = h;
                __syncthreads();
                float carry = 0.f, pref = 1.f;
                for (int j = 0; j < sub; ++j) { const float A = subA[j * 128 + ch]; carry = A * carry + subH[j * 128 + ch]; pref *= A; }
#pragma unroll 4
                for (int s = 0; s < 16; ++s) { const int t = sub * 16 + s; const size_t o = (size_t)(row0 + t) * DL + chg;
                    hlb[o] = uL[t * 128 + ch] + aL[t * 128 + ch] * carry; ppb[o] = aL[t * 128 + ch] * pref; }
                if (sub == 3) { const float A3 = subA[3 * 128 + ch]; float* so = summ + ((size_t)(b * 32 + c) * DL + chg) * 2; so[0] = pref * A3; so[1] = A3 * carry + subH[3 * 128 + ch]; }
            } else {
#pragma unroll
                for (int q = 0; q < 4; ++q) { const int sl = sub * 4 + q, sq = c * 16 + sl;
                    float h = P.in[2][(size_t)(l * DB + sq) * DL + chg];
#pragma unroll
                    for (int t = 0; t < 4; ++t) { const int r = sl * 4 + t; h = aL[r * 128 + ch] * h + uL[r * 128 + ch]; const size_t o = (size_t)(row0 + r) * DL + chg; hlb[o] = h; ppb[o] = 0.f; }
                    P.out[O_LH_S + (size_t)(l * DB + sq) * DL + chg] = h; }
            }
        }
        __syncthreads();
    }
}

__device__ __forceinline__ void phase2c(int l, LAS unsigned char* lds) {
    const CAS Params& P = kparams();
    int tid_ = threadIdx.x; asm volatile("" : "+v"(tid_));
    const int tid = tid_;
    LAS float* carryL = (LAS float*)lds;
    LAS float* partL = carryL + 128;
    const bf16_t* z = (const bf16_t*)(P.ws + WS_Z);
    const float* hlb = (const float*)(P.ws + WS_HL); const float* ppb = (const float*)(P.ws + WS_PP); const float* summ = (const float*)(P.ws + WS_SUM);
    bf16_t* ymix = (bf16_t*)(P.ws + WS_YMIX);
    for (int tile2 = blockIdx.x; tile2 < 2 * N_LRU_TILES; tile2 += gridDim.x) {
        const bool is_sc = tile2 >= N_LRU_TILES; const int tile = is_sc ? tile2 - N_LRU_TILES : tile2;
        const bool smp = tile >= 1024;
        int b = 0, hd, c;
        if (!smp) { hd = tile & 7; c = (tile >> 3) & 31; b = tile >> 8; } else { const int s = tile - 1024; hd = s & 7; c = s >> 3; }
        const int row0 = smp ? NPR + c * 64 : b * SEQ + c * 64;
        const int g = tid & 15, chl = g * 8, ch0 = hd * 128 + chl;
        if (!is_sc) {
            {
                const int ch = tid & 127, part = tid >> 7, chg = hd * 128 + ch; float A = 1.f, H = 0.f;
                if (!smp) {
                    typedef float f32x2 __attribute__((ext_vector_type(2)));
                    f32x2 sv[8];
#pragma unroll
                    for (int jj = 0; jj < 8; ++jj) { const int j = part * 8 + jj, jl = j < c ? j : 0; sv[jj] = *(const f32x2*)(summ + ((size_t)(b * 32 + jl) * DL + chg) * 2); }
#pragma unroll
                    for (int jj = 0; jj < 8; ++jj) { const bool on = part * 8 + jj < c; const float sa = on ? sv[jj][0] : 1.f, sh = on ? sv[jj][1] : 0.f; H = sa * H + sh; A *= sa; }
                }
                partL[tid] = A; partL[512 + tid] = H;
                __syncthreads();
                if (tid < 128) { float carry = 0.f;
#pragma unroll
                    for (int p = 0; p < 4; ++p) carry = partL[p * 128 + tid] * carry + partL[512 + p * 128 + tid];
                    carryL[tid] = carry; }
            }
            __syncthreads();
            const f32x4 c0 = *(const LAS f32x4*)(carryL + chl), c1 = *(const LAS f32x4*)(carryL + chl + 4);
            const f32x4 gn0 = *(const f32x4*)(P.in[16] + l * DL + ch0), gn1 = *(const f32x4*)(P.in[16] + l * DL + ch0 + 4);
#pragma unroll
            for (int it = 0; it < 2; ++it) {
                const int r = (tid >> 4) + it * 32; const size_t o = (size_t)(row0 + r) * DL + ch0;
                const f32x4 h0 = *(const f32x4*)(hlb + o) + *(const f32x4*)(ppb + o) * c0, h1 = *(const f32x4*)(hlb + o + 4) + *(const f32x4*)(ppb + o + 4) * c1;
                const u32x4 gw = *(const u32x4*)(z + (size_t)(row0 + r) * NIN + DL + ch0); f32x4 g0, g1; UNPACK8(gw, g0, g1);
                f32x4 y0, y1; float ss = 0.f;
#pragma unroll
                for (int j = 0; j < 4; ++j) { y0[j] = h0[j] * g0[j] * sigmoidf_(g0[j]); y1[j] = h1[j] * g1[j] * sigmoidf_(g1[j]); ss += y0[j] * y0[j] + y1[j] * y1[j]; }
                ss += __shfl_xor(ss, 1); ss += __shfl_xor(ss, 2); ss += __shfl_xor(ss, 4); ss += __shfl_xor(ss, 8);
                const float sc = rsqrtf(ss * (1.0f / 128.0f) + 1e-6f);
                *(u32x4*)(ymix + (size_t)(row0 + r) * DM + ch0) = pack8(y0 * sc * gn0, y1 * sc * gn1);
                if (!smp && c == 31 && r == 63) { float* oh = P.out + O_LH_P + (size_t)(l * NB + b) * DL + ch0; *(f32x4*)oh = h0; *(f32x4*)(oh + 4) = h1; }
            }
            __syncthreads();
        } else {
            const float* sw = P.in[15] + (size_t)l * 3 * DL;
            f32x4 w[3][2];
#pragma unroll
            for (int k = 0; k < 3; ++k) { w[k][0] = *(const f32x4*)(sw + k * DL + ch0); w[k][1] = *(const f32x4*)(sw + k * DL + ch0 + 4); }
            const f32x4 gn0 = *(const f32x4*)(P.in[17] + l * DL + ch0), gn1 = *(const f32x4*)(P.in[17] + l * DL + ch0 + 4);
#pragma unroll
            for (int it = 0; it < 2; ++it) {
                const int r = (tid >> 4) + it * 32;
                f32x4 v0 = (f32x4){0.f, 0.f, 0.f, 0.f}, v1 = v0;
#pragma unroll
                for (int k = 0; k < 3; ++k) {
                    f32x4 q0, q1; bool have = true, fromz = true; int tt;
                    if (!smp) { tt = c * 64 + r - k; have = tt >= 0; } else { tt = (r & 3) - k; fromz = tt >= 0; }
                    if (!have) { q0 = (f32x4){0.f, 0.f, 0.f, 0.f}; q1 = q0; }
                    else if (fromz) { const bf16_t* zr = z + (size_t)(row0 + r - k) * NIN + ch0; const u32x4 cv = *(const u32x4*)(zr + 3 * DL), hv = *(const u32x4*)(zr + 4 * DL);
                        f32x4 cc0, cc1, hh0, hh1; UNPACK8(cv, cc0, cc1); UNPACK8(hv, hh0, hh1); q0 = cc0 * hh0; q1 = cc1 * hh1; }
                    else { const int sq = c * 16 + (r >> 2); const float* sp = P.in[4] + ((size_t)(l * DB + sq) * 2 + (2 + tt)) * DL + ch0; q0 = *(const f32x4*)sp; q1 = *(const f32x4*)(sp + 4); }
                    v0 += w[2 - k][0] * q0; v1 += w[2 - k][1] * q1;
                    if (k == 0) {
                        if (!smp) { if (c == 31 && r >= 62) { float* o = P.out + O_SC_P + ((size_t)(l * NB + b) * 2 + (r - 62)) * DL + ch0; *(f32x4*)o = q0; *(f32x4*)(o + 4) = q1; } }
                        else if ((r & 3) >= 2) { const int sq = c * 16 + (r >> 2); float* o = P.out + O_SC_S + ((size_t)(l * DB + sq) * 2 + ((r & 3) - 2)) * DL + ch0; *(f32x4*)o = q0; *(f32x4*)(o + 4) = q1; }
                    }
                }
                const bf16_t* zr = z + (size_t)(row0 + r) * NIN + ch0;
                const u32x4 bw = *(const u32x4*)(zr + 2 * DL), gw = *(const u32x4*)(zr + 5 * DL);
                f32x4 b0, b1, g0, g1; UNPACK8(bw, b0, b1); UNPACK8(gw, g0, g1);
                f32x4 y0, y1; float ss = 0.f;
#pragma unroll
                for (int j = 0; j < 4; ++j) { y0[j] = b0[j] * v0[j] * g0[j] * sigmoidf_(g0[j]); y1[j] = b1[j] * v1[j] * g1[j] * sigmoidf_(g1[j]); ss += y0[j] * y0[j] + y1[j] * y1[j]; }
                ss += __shfl_xor(ss, 1); ss += __shfl_xor(ss, 2); ss += __shfl_xor(ss, 4); ss += __shfl_xor(ss, 8);
                const float sc = rsqrtf(ss * (1.0f / 128.0f) + 1e-6f);
                *(u32x4*)(ymix + (size_t)(row0 + r) * DM + DL + ch0) = pack8(y0 * sc * gn0, y1 * sc * gn1);
            }
        }
    }
}

__device__ __forceinline__ void phase4(int l) {
    const CAS Params& P = kparams();
    int tid_ = threadIdx.x; asm volatile("" : "+v"(tid_));
    const int lane = tid_ & 63, wv = (blockIdx.x * 512 + tid_) >> 6, nwv = gridDim.x * 8;
    const float* lg = P.in[22] + l * DM; const float* lb = P.in[23] + l * DM;
    bf16_t* xb = (bf16_t*)(P.ws + WS_XB); const bf16_t* tb = (const bf16_t*)(P.ws + WS_YMIX);
    for (int row = wv; row < MT; row += nwv) {
        f32x4 v[8]; float s = 0.f;
#pragma unroll
        for (int i = 0; i < 4; ++i) { const u32x4 w = *(const u32x4*)(tb + (size_t)row * DM + i * 512 + lane * 8); UNPACK8(w, v[2 * i], v[2 * i + 1]); }
#pragma unroll
        for (int i = 0; i < 8; ++i) s += (v[i][0] + v[i][1]) + (v[i][2] + v[i][3]);
#pragma unroll
        for (int o = 32; o >= 1; o >>= 1) s += __shfl_xor(s, o);
        const float mean = s * (1.0f / DM); float q = 0.f;
#pragma unroll
        for (int i = 0; i < 8; ++i) { v[i] = v[i] - mean; q += (v[i][0] * v[i][0] + v[i][1] * v[i][1]) + (v[i][2] * v[i][2] + v[i][3] * v[i][3]); }
#pragma unroll
        for (int o = 32; o >= 1; o >>= 1) q += __shfl_xor(q, o);
        const float rstd = rsqrtf(q * (1.0f / DM) + 1e-5f);
#pragma unroll
        for (int i = 0; i < 4; ++i) { const int col = i * 512 + lane * 8;
            const f32x4 y0 = v[2 * i] * rstd * *(const f32x4*)(lg + col) + *(const f32x4*)(lb + col), y1 = v[2 * i + 1] * rstd * *(const f32x4*)(lg + col + 4) + *(const f32x4*)(lb + col + 4);
            if (l + 1 < NLAYER) *(u32x4*)(xb + (size_t)row * DM + col) = pack8(y0, y1);
            else { float* rp = P.out + (size_t)row * DM + col; *(f32x4*)rp = y0; *(f32x4*)(rp + 4) = y1; } }
    }
}

#define XB_TMO      128
#define XB_XCNT(j)  (256  + 64 * (j))
#define XB_XSUB(j)  (1280 + 64 * (j))
#define XB_XGEN(j)  (2304 + 64 * (j))
#define XB_TOP      3328
#define XB_TOPGEN   3392
#define XCD_BAR_WORDS 3456
#define XB_SPIN_CAP (1u << 18)
__device__ __forceinline__ unsigned xb_ld(unsigned* p)              { return __hip_atomic_load(p, __ATOMIC_RELAXED, __HIP_MEMORY_SCOPE_AGENT); }
__device__ __forceinline__ unsigned xb_add(unsigned* p, unsigned v) { return __hip_atomic_fetch_add(p, v, __ATOMIC_RELAXED, __HIP_MEMORY_SCOPE_AGENT); }
__device__ __forceinline__ unsigned xb_xcc_id() { return (unsigned)__builtin_amdgcn_s_getreg((3 << 11) | 20) & 0xFu; }
#define XB_SPIN(cond, bar) do { unsigned _sp = 0; while (cond) { __builtin_amdgcn_s_sleep(1); \
    if ((++_sp & 255u) == 0u) { if (xb_ld(&(bar)[XB_TMO])) break; if (_sp > XB_SPIN_CAP) { atomicAdd(&(bar)[XB_TMO], 1u); break; } } } } while (0)
struct XcdBarrier { unsigned* bar; unsigned x; volatile LAS unsigned* st; };
__device__ __forceinline__ XcdBarrier xcd_barrier_post(unsigned* bar, volatile LAS unsigned* st) {
    XcdBarrier b; b.bar = bar; b.x = xb_xcc_id(); b.st = st;
    if (threadIdx.x == 0) (void)xb_add(&bar[XB_XCNT(b.x)], 1u);
    return b;
}
__device__ __forceinline__ void xcd_barrier_complete(unsigned* bar, unsigned x, unsigned& nloc, unsigned& nx) {
    const unsigned G = gridDim.x * gridDim.y * gridDim.z;
    unsigned sum, cnt, mine, sp = 0u;
    for (;;) {
        sum = 0u; cnt = 0u; mine = 0u;
#pragma unroll
        for (unsigned j = 0; j < 16; ++j) { const unsigned c = xb_ld(&bar[XB_XCNT(j)]); sum += c; cnt += (c > 0u) ? 1u : 0u; mine = (j == x) ? c : mine; }
        if (sum == G) break;
        __builtin_amdgcn_s_sleep(1);
        if ((++sp & 255u) == 0u) { if (xb_ld(&bar[XB_TMO])) break; if (sp > XB_SPIN_CAP) { atomicAdd(&bar[XB_TMO], 1u); break; } }
    }
    nloc = mine > 0u ? mine : 1u; nx = cnt > 0u ? cnt : 1u;
}
__device__ __forceinline__ void xcd_barrier(const XcdBarrier& b) {
    asm volatile("s_waitcnt vmcnt(0)" ::: "memory");
    __syncthreads();
    if (threadIdx.x == 0) {
        unsigned* bar = b.bar;
        __builtin_amdgcn_s_waitcnt(0);
        unsigned nloc = b.st[0], nx = b.st[1];
        if (nloc == 0u) { xcd_barrier_complete(bar, b.x, nloc, nx); b.st[0] = nloc; b.st[1] = nx; }
        const unsigned old = xb_add(&bar[XB_XSUB(b.x)], 1u);
        const unsigned gen = old / nloc;
        if (old + 1u == (gen + 1u) * nloc) {
            __builtin_amdgcn_fence(__ATOMIC_RELEASE, "agent");
            asm volatile("s_waitcnt vmcnt(0)" ::: "memory");
            const unsigned og = xb_add(&bar[XB_TOP], 1u);
            const unsigned tg = og / nx;
            if (og + 1u == (tg + 1u) * nx) xb_add(&bar[XB_TOPGEN], 1u);
            else XB_SPIN(xb_ld(&bar[XB_TOPGEN]) == tg, bar);
            __builtin_amdgcn_fence(__ATOMIC_ACQUIRE, "agent");
            xb_add(&bar[XB_XGEN(b.x)], 1u);
            asm volatile("s_waitcnt vmcnt(0)" ::: "memory");
        } else {
            XB_SPIN(xb_ld(&bar[XB_XGEN(b.x)]) == gen, bar);
            __builtin_amdgcn_fence(__ATOMIC_ACQUIRE, "agent");
            asm volatile("s_waitcnt vmcnt(0)" ::: "memory");
        }
    }
    __syncthreads();
}

__global__ void __launch_bounds__(512, 2) mega_fwd(Params Pk) {
    extern __shared__ __attribute__((aligned(16))) unsigned char lds_raw[];
    LAS unsigned char* lds = (LAS unsigned char*)lds_raw;
    int ph = 0;
    if (threadIdx.x < 4) ((LAS unsigned*)(lds + 131072))[threadIdx.x] = 0u;
    __syncthreads();
    XcdBarrier xbar = xcd_barrier_post((unsigned*)(Pk.ws + WS_BAR), (volatile LAS unsigned*)(lds + 131072));
#ifndef PROBE_PH
#define PROBE_PH -1
#endif
#define RUN(k) ((k) >= Pk.ph_lo && (k) < Pk.ph_hi)
#define SEAM(k) do { if ((k) + 1 < Pk.ph_hi) xcd_barrier(xbar); } while (0)
#define REPS(k) (((k) == PROBE_PH) ? 2 : 1)
    if (RUN(ph)) { for (int rp = 0; rp < REPS(0); ++rp) { phase0(lds); SEAM(ph); } } ++ph;
#pragma unroll 1
    for (int l = 0; l < NLAYER; ++l) {
        if (RUN(ph)) for (int rp = 0; rp < REPS(1 + (l == 0 ? 0 : 100)); ++rp) {
            const CAS Params& P = kparams(); unsigned char* ws = P.ws;
            { pg8::Gemm g{(const bf16_t*)(ws + WS_XB), (const bf16_t*)(ws + WS_WIN) + (size_t)l * NIN * DM, NPR, NIN, DM};
              pg8::StaticOrder S; S.init(NPR, NIN, gridDim.x, blockIdx.x);
              pg8::EpiBf16 E{(bf16_t*)(ws + WS_Z), NIN};
              pg8::gemm_phase(lds, g, S, E); }
            { pg8::Gemm g{(const bf16_t*)(ws + WS_PB) + (size_t)l * MT * DPLE, (const bf16_t*)(ws + WS_WP) + (size_t)l * DM * DPLE, NPR, DM, DPLE};
              pg8::StaticOrder S; S.init(NPR, DM, gridDim.x, blockIdx.x);
              pg8::EpiBf16 E{(bf16_t*)(ws + WS_E), DM};
              pg8::gemm_phase(lds, g, S, E); }
            SEAM(ph);
        } ++ph;
        if (RUN(ph)) for (int rp = 0; rp < REPS(2 + (l == 0 ? 0 : 100)); ++rp) { phase2a(l, lds); SEAM(ph); } ++ph;
        if (RUN(ph)) for (int rp = 0; rp < REPS(3 + (l == 0 ? 0 : 100)); ++rp) { phase2c(l, lds); SEAM(ph); } ++ph;
        if (RUN(ph)) for (int rp = 0; rp < REPS(4 + (l == 0 ? 0 : 100)); ++rp) {
            const CAS Params& P = kparams(); unsigned char* ws = P.ws;
            pg8::Gemm g{(const bf16_t*)(ws + WS_YMIX), (const bf16_t*)(ws + WS_WOUT) + (size_t)l * DM * DM, NPR, DM, DM};
            pg8::StaticOrder S; S.init(NPR, DM, gridDim.x, blockIdx.x);
            pg8::EpiRes E{(const bf16_t*)(ws + WS_XB), (bf16_t*)(ws + WS_RB)};
            pg8::gemm_phase(lds, g, S, E);
            SEAM(ph);
        } ++ph;
        if (RUN(ph)) for (int rp = 0; rp < REPS(5 + (l == 0 ? 0 : 100)); ++rp) {
            const CAS Params& P = kparams(); unsigned char* ws = P.ws;
            pg8::Gemm g{(const bf16_t*)(ws + WS_RB), (const bf16_t*)(ws + WS_WG) + (size_t)l * DM * DM, NPR, DM, DM};
            pg8::StaticOrder S; S.init(NPR, DM, gridDim.x, blockIdx.x);
            pg8::EpiGate E{(const bf16_t*)(ws + WS_RB), (const bf16_t*)(ws + WS_E), P.in[21] + l * DM, (bf16_t*)(ws + WS_YMIX)};
            pg8::gemm_phase(lds, g, S, E);
            SEAM(ph);
        } ++ph;
        if (RUN(ph)) for (int rp = 0; rp < REPS(6 + (l == 0 ? 0 : 100)); ++rp) { phase4(l); SEAM(ph); } ++ph;
    }
}
constexpr int N_PHASES = 1 + 6 * NLAYER;
constexpr int LDS_BYTES = 131072 + 16;

extern "C" void kernel_launch(void* const* d_in, const int* in_sizes, int n_in, void* d_out, int out_size, void* d_ws, size_t ws_size, hipStream_t stream) {
    static int grid = 0;
    if (grid == 0) {
        if (n_in != 24 || ws_size < WS_END) { fprintf(stderr, "kernel_launch: need 24 inputs and >= %zu bytes of workspace (got %d, %zu)\n", (size_t)WS_END, n_in, ws_size); grid = -1; return; }
        int dev = 0, cus = 0, per_cu = 0;
        hipGetDevice(&dev); hipDeviceGetAttribute(&cus, hipDeviceAttributeMultiprocessorCount, dev);
        if (hipFuncSetAttribute((const void*)mega_fwd, hipFuncAttributeMaxDynamicSharedMemorySize, LDS_BYTES) != hipSuccess) { fprintf(stderr, "kernel_launch: hipFuncSetAttribute failed\n"); grid = -1; return; }
        if (hipOccupancyMaxActiveBlocksPerMultiprocessor(&per_cu, (const void*)mega_fwd, 512, LDS_BYTES) != hipSuccess || per_cu < 1) { fprintf(stderr, "kernel_launch: occupancy query failed (%d)\n", per_cu); grid = -1; return; }
        grid = cus * per_cu;
        fprintf(stderr, "kernel_launch: grid %d (%d CUs x %d)\n", grid, cus, per_cu);
    }
    if (grid < 0) return;
    if (hipMemsetAsync((char*)d_ws + WS_BAR, 0, XCD_BAR_WORDS * 4, stream) != hipSuccess) { fprintf(stderr, "kernel_launch: memset failed\n"); return; }
    Params p{};
    for (int i = 0; i < 24; ++i) p.in[i] = (const float*)d_in[i];
    p.out = (float*)d_out; p.ws = (unsigned char*)d_ws; p.ph_lo = 0; p.ph_hi = N_PHASES;
    void* args[] = {&p};
    hipError_t e = hipLaunchCooperativeKernel((const void*)mega_fwd, dim3(grid), dim3(512), args, LDS_BYTES, stream);
    if (e != hipSuccess) fprintf(stderr, "kernel_launch: cooperative launch failed: %s (grid %d)\n", hipGetErrorString(e), grid);
}
```

```cpp
#include <hip/hip_runtime.h>
#include <hip/hip_cooperative_groups.h>
#include <cstdio>
namespace cg = cooperative_groups;

#define LAS __attribute__((address_space(3)))
typedef unsigned short bf16_t;
typedef short bf16x8 __attribute__((ext_vector_type(8)));
typedef float f32x4 __attribute__((ext_vector_type(4)));
typedef unsigned u32x4 __attribute__((ext_vector_type(4)));
typedef unsigned u32x2 __attribute__((ext_vector_type(2)));

constexpr int DM = 2048, NPR = 8192, NSR = 512, MT = 8704, NLAYER = 2, DL = 1024, NIN = 6144, DPLE = 256, SEQ = 2048, NB = 4, DB = 128;
constexpr float ALPHA = 1.4142135623730951f;
constexpr size_t O_Y = 0, O_LH_P = (size_t)MT * DM, O_LC_P = O_LH_P + 2 * 4 * 1024, O_SC_P = O_LC_P + 2 * 4 * 3 * 1024,
                 O_LH_S = O_SC_P + 2 * 4 * 2 * 1024, O_LC_S = O_LH_S + 2 * 128 * 1024, O_SC_S = O_LC_S + 2 * 128 * 3 * 1024;
constexpr size_t SZ_ACT = (size_t)MT * DM * 2;
constexpr size_t WS_XB = 0, WS_PB = WS_XB + SZ_ACT, WS_WIN = WS_PB + (size_t)2 * MT * 256 * 2, WS_WOUT = WS_WIN + (size_t)2 * NIN * DM * 2,
                 WS_WG = WS_WOUT + (size_t)2 * DM * DM * 2, WS_WP = WS_WG + (size_t)2 * DM * DM * 2, WS_WA = WS_WP + (size_t)2 * DM * 256 * 2,
                 WS_WX = WS_WA + 524288, WS_SUM = WS_WX + 524288, WS_Z = WS_SUM + 1048576, WS_HL = WS_Z + (size_t)MT * NIN * 2,
                 WS_PP = WS_HL + SZ_ACT, WS_YMIX = WS_PP + SZ_ACT, WS_E = WS_YMIX + SZ_ACT, WS_BAR = WS_E + SZ_ACT, WS_END = WS_BAR + 16384;
constexpr size_t WS_RB = WS_HL;

struct Params { const float* in[24]; float* out; unsigned char* ws; int ph_lo, ph_hi; };
#define CAS __attribute__((address_space(4)))
__device__ __forceinline__ const CAS Params& kparams() { const CAS Params* p = (const CAS Params*)__builtin_amdgcn_kernarg_segment_ptr(); asm volatile("" : "+s"(p)); return *p; }

__device__ __forceinline__ unsigned cvt_pk_bf16(float lo, float hi) { unsigned r; asm volatile("v_cvt_pk_bf16_f32 %0, %1, %2" : "=v"(r) : "v"(lo), "v"(hi)); return r; }
__device__ __forceinline__ float bf_lo(unsigned w) { return __uint_as_float(w << 16); }
__device__ __forceinline__ float bf_hi(unsigned w) { return __uint_as_float(w & 0xffff0000u); }
__device__ __forceinline__ float sigmoidf_(float x) { return __builtin_amdgcn_rcpf(1.0f + __expf(-x)); }
__device__ __forceinline__ u32x4 pack8(const f32x4 a, const f32x4 b) { u32x4 w; w.x = cvt_pk_bf16(a[0], a[1]); w.y = cvt_pk_bf16(a[2], a[3]); w.z = cvt_pk_bf16(b[0], b[1]); w.w = cvt_pk_bf16(b[2], b[3]); return w; }
__device__ __forceinline__ void unpack8_(const u32x4 q, f32x4& lo, f32x4& hi) { lo = (f32x4){bf_lo(q[0]), bf_hi(q[0]), bf_lo(q[1]), bf_hi(q[1])}; hi = (f32x4){bf_lo(q[2]), bf_hi(q[2]), bf_lo(q[3]), bf_hi(q[3])}; }
#define UNPACK8(q_, lo_, hi_) unpack8_(q_, lo_, hi_)

namespace pg8 {
constexpr int BM = 256, BK = 64, HALF = 128, HTB = HALF * BK * 2, STAGE_BYTES = 8 * HTB, NXCD = 8, WGM = 8;
__host__ __device__ __forceinline__ int lds_byte(int r, int c) { const int st = (r >> 4) * 2 + (c >> 5), rr = r & 15, cc = c & 31, ob = rr * 64 + cc * 2; return st * 1024 + (ob ^ (((ob >> 9) & 1) << 5)); }
__host__ __device__ __forceinline__ void stage_rc(int b, int& R, int& C) { const int st = b / 1024, sb = b % 1024, swz = sb ^ (((sb >> 9) & 1) << 5); R = (st >> 1) * 16 + swz / 64; C = (st & 1) * 32 + (swz % 64) / 2; }
__host__ __device__ __forceinline__ int perm32(int rho) { const int n = rho >> 4, i = rho & 15; return 8 * (i >> 2) + 4 * n + (i & 3); }
struct Unit { int pm, pn; };
struct Gemm { const bf16_t* A; const bf16_t* Bt; int M, N, K; };
struct StaticOrder {
    int nM, nN, nwg, G, c;
    __device__ void init(int M, int N, int G_, int c_) { nM = M / BM; nN = N / BM; nwg = nM * nN; G = G_; c = c_; }
    __device__ bool next(int i, Unit& u) const {
        const long L = (long)i * G + c; if (L >= nwg || c < 0) return false;
        int wgid = (int)L; { const int q = nwg / NXCD, r = nwg % NXCD, xcd = wgid % NXCD, off = wgid / NXCD; wgid = (xcd < r ? xcd * (q + 1) : r * (q + 1) + (xcd - r) * q) + off; }
        const int nig = WGM * nN, gid = wgid / nig, fm = gid * WGM, gsz = (nM - fm) < WGM ? (nM - fm) : WGM;
        u.pm = fm + ((wgid % nig) % gsz); u.pn = (wgid % nig) / gsz; return true;
    }
};
struct EpiBf16 {
    bf16_t* O; int ldc;
    __device__ __forceinline__ void emit(int row, int col, const f32x4 v0, const f32x4 v1) const { *(u32x4*)(O + (size_t)row * ldc + col) = pack8(v0, v1); }
};
struct EpiRes {
    const bf16_t* xb; bf16_t* rb;
    __device__ __forceinline__ void emit(int row, int col, const f32x4 v0, const f32x4 v1) const {
        const size_t off = (size_t)row * DM + col; const u32x4 xw = *(const u32x4*)(xb + off); f32x4 x0, x1; UNPACK8(xw, x0, x1);
        *(u32x4*)(rb + off) = pack8(v0 + ALPHA * x0, v1 + ALPHA * x1); }
};
struct EpiGate {
    const bf16_t* rb; const bf16_t* e; const float* bg; bf16_t* tb;
    __device__ __forceinline__ void emit(int row, int col, const f32x4 v0, const f32x4 v1) const {
        const size_t off = (size_t)row * DM + col;
        const u32x4 rw = *(const u32x4*)(rb + off), ew = *(const u32x4*)(e + off); f32x4 r0, r1, e0, e1; UNPACK8(rw, r0, r1); UNPACK8(ew, e0, e1);
        f32x4 g0 = v0 + *(const f32x4*)(bg + col), g1 = v1 + *(const f32x4*)(bg + col + 4);
#pragma unroll
        for (int j = 0; j < 4; ++j) { g0[j] = sigmoidf_(g0[j]); g1[j] = sigmoidf_(g1[j]); }
        *(u32x4*)(tb + off) = pack8(r0 + g0 * e0, r1 + g1 * e1); }
};

template <class Epi, class Sched>
__device__ __forceinline__ void gemm_phase(LAS unsigned char* lds, const Gemm g, const Sched& S, const Epi& E) {
    int tid_ = threadIdx.x; asm volatile("" : "+v"(tid_));
    const int tid = tid_, wid = __builtin_amdgcn_readfirstlane(tid >> 6), lane = tid & 63, wr = wid >> 2, wc = wid & 3, fr = lane & 15, fq = lane >> 4;
    const int K = g.K, nt = K / BK;
    unsigned voffA, voffB;
    { int R, C; stage_rc(tid * 16, R, C); const int Rb = (R & ~31) + perm32(R & 31); voffA = (unsigned)(R * K + C) * 2u; voffB = (unsigned)(Rb * K + C) * 2u; }
    const size_t qstep = (size_t)64 * K * 2;
    const size_t kstep = (size_t)(BK * 2);
    const size_t hstep = (size_t)HALF * K * 2;
    const size_t tstep = 2 * hstep;
    const unsigned ldsw = (unsigned)wid * 1024u;
    const int aoff = lds_byte(wr * 64 + fr, fq * 8), boff = lds_byte(wc * 32 + fr, fq * 8);
    const unsigned xoff = (unsigned)(fr * K + fq * 8) * 2u;
#define PG8_SA(b, h) (((b) * 2 + (h)) * HTB)
#define PG8_SB(b, h) ((4 + (b) * 2 + (h)) * HTB)
#define PG8_STAGE(bufoff, gbase, voff) do { _Pragma("unroll") for (int _i = 0; _i < 2; ++_i) \
        __builtin_amdgcn_global_load_lds((const unsigned*)((const char*)(gbase) + _i * qstep + (voff)), (LAS unsigned*)(lds + (bufoff) + ldsw + _i * 8192), 16, 0, 0); } while (0)
#define PG8_LDA(dst, b, h) do { _Pragma("unroll") for (int m = 0; m < 4; ++m) _Pragma("unroll") for (int k = 0; k < 2; ++k) dst[m][k] = *(const LAS bf16x8*)(lds + PG8_SA(b, h) + aoff + m * 2048 + k * 1024); } while (0)
#define PG8_LDB(dst, b, h) do { _Pragma("unroll") for (int n = 0; n < 2; ++n) _Pragma("unroll") for (int k = 0; k < 2; ++k) dst[n][k] = *(const LAS bf16x8*)(lds + PG8_SB(b, h) + boff + n * 2048 + k * 1024); } while (0)
#define PG8_MMA(ai, bj, At, Bt) do { __builtin_amdgcn_s_setprio(1); _Pragma("unroll") for (int m = 0; m < 4; ++m) _Pragma("unroll") for (int n = 0; n < 2; ++n) _Pragma("unroll") for (int k = 0; k < 2; ++k) \
        acc[ai][bj][m][n] = __builtin_amdgcn_mfma_f32_16x16x32_bf16(Bt[n][k], At[m][k], acc[ai][bj][m][n], 0, 0, 0); __builtin_amdgcn_s_setprio(0); } while (0)
#define PG8_LDX(kt) do { const char* _x = cX + (size_t)(kt) * kstep; \
        asm volatile("global_load_dwordx4 %0, %2, %3\n\tglobal_load_dwordx4 %1, %2, %3 offset:64" : "=&v"(ax[0]), "=&v"(ax[1]) : "v"(xoff), "s"(_x) : "memory"); } while (0)
#define PG8_XREADY() asm volatile("" : "+v"(ax[0]), "+v"(ax[1]))
#define PG8_XMMA() do { if (wr == 0) { _Pragma("unroll") for (int n = 0; n < 2; ++n) _Pragma("unroll") for (int k = 0; k < 2; ++k) accx[n] = __builtin_amdgcn_mfma_f32_16x16x32_bf16(B0[n][k], ax[k], accx[n], 0, 0, 0); } \
        else { _Pragma("unroll") for (int n = 0; n < 2; ++n) _Pragma("unroll") for (int k = 0; k < 2; ++k) accx[n] = __builtin_amdgcn_mfma_f32_16x16x32_bf16(B1[n][k], ax[k], accx[n], 0, 0, 0); } } while (0)
#define PG8_WAIT_V(n) asm volatile("s_waitcnt vmcnt(" #n ")" ::: "memory")
#define PG8_WAIT_L(n) asm volatile("s_waitcnt lgkmcnt(" #n ")" ::: "memory")
#define PG8_BAR __builtin_amdgcn_s_barrier()
#define PG8_SCHED __builtin_amdgcn_sched_barrier(0)
    Unit cur, nxt; int ui = 0;
    if (!S.next(0, cur)) return;
    f32x4 acc[2][2][4][2], accx[2];
#pragma unroll
    for (int a = 0; a < 2; ++a)
#pragma unroll
        for (int b = 0; b < 2; ++b)
#pragma unroll
            for (int m = 0; m < 4; ++m)
#pragma unroll
                for (int n = 0; n < 2; ++n) acc[a][b][m][n] = (f32x4){0.f, 0.f, 0.f, 0.f};
    accx[0] = (f32x4){0.f, 0.f, 0.f, 0.f}; accx[1] = accx[0];
    bf16x8 At[4][2], B0[2][2], B1[2][2], ax[2];
    const char* cA = (const char*)g.A + (size_t)cur.pm * tstep; const char* cB = (const char*)g.Bt + (size_t)cur.pn * tstep;
    const char* cX = (const char*)g.A + ((size_t)NPR + 16 * cur.pm) * K * 2;
    PG8_STAGE(PG8_SB(0, 0), cB, voffB); PG8_STAGE(PG8_SA(0, 0), cA, voffA); PG8_STAGE(PG8_SB(0, 1), cB + hstep, voffB); PG8_STAGE(PG8_SA(0, 1), cA + hstep, voffA);
    if (wr == 1) PG8_BAR;
    PG8_WAIT_V(4); PG8_BAR;
    PG8_STAGE(PG8_SB(1, 0), cB + kstep, voffB); PG8_STAGE(PG8_SA(1, 0), cA + kstep, voffA); PG8_STAGE(PG8_SB(1, 1), cB + hstep + kstep, voffB);
    PG8_WAIT_V(6); PG8_BAR;
    for (;;) {
        const bool has_next = S.next(ui + 1, nxt);
        const char* nA = has_next ? (const char*)g.A + (size_t)nxt.pm * tstep : cA; const char* nB = has_next ? (const char*)g.Bt + (size_t)nxt.pn * tstep : cB;
        for (int t = 0; t < nt; t += 2) {
            const bool last = (t == nt - 2);
            const char* a1 = cA + (size_t)(t + 1) * kstep;
            const char* a2 = last ? nA : cA + (size_t)(t + 2) * kstep; const char* b2 = last ? nB : cB + (size_t)(t + 2) * kstep;
            const char* a3 = a2 + kstep; const char* b3 = b2 + kstep;
            PG8_LDB(B0, 0, 0); PG8_SCHED; PG8_LDA(At, 0, 0); PG8_STAGE(PG8_SA(1, 1), a1 + hstep, voffA); PG8_LDX(t);
            PG8_WAIT_L(8); PG8_BAR; PG8_WAIT_L(0); PG8_MMA(0, 0, At, B0); PG8_BAR; PG8_SCHED;
            PG8_LDB(B1, 0, 1); PG8_STAGE(PG8_SB(0, 0), b2, voffB);
            PG8_BAR; PG8_WAIT_L(0); PG8_MMA(0, 1, At, B1); PG8_BAR;
            PG8_LDA(At, 0, 1); PG8_STAGE(PG8_SA(0, 0), a2, voffA);
            PG8_BAR; PG8_WAIT_L(0); PG8_MMA(1, 0, At, B0); PG8_BAR; PG8_SCHED;
            PG8_STAGE(PG8_SB(0, 1), b2 + hstep, voffB);
            PG8_WAIT_V(6); PG8_XREADY(); PG8_BAR; PG8_MMA(1, 1, At, B1); PG8_XMMA(); PG8_BAR; PG8_SCHED;
            PG8_LDB(B0, 1, 0); PG8_SCHED; PG8_LDA(At, 1, 0); PG8_STAGE(PG8_SA(0, 1), a2 + hstep, voffA); PG8_LDX(t + 1);
            PG8_WAIT_L(8); PG8_BAR; PG8_WAIT_L(0); PG8_MMA(0, 0, At, B0); PG8_BAR; PG8_SCHED;
            PG8_LDB(B1, 1, 1); PG8_STAGE(PG8_SB(1, 0), b3, voffB);
            PG8_BAR; PG8_WAIT_L(0); PG8_MMA(0, 1, At, B1); PG8_BAR;
            PG8_LDA(At, 1, 1); PG8_STAGE(PG8_SA(1, 0), a3, voffA);
            PG8_BAR; PG8_WAIT_L(0); PG8_MMA(1, 0, At, B0); PG8_BAR; PG8_SCHED;
            PG8_STAGE(PG8_SB(1, 1), b3 + hstep, voffB);
            PG8_WAIT_V(6); PG8_XREADY(); PG8_BAR; PG8_MMA(1, 1, At, B1); PG8_XMMA(); PG8_BAR; PG8_SCHED;
        }
        {
            const int row0 = cur.pm * BM + wr * 64 + fr, col0 = cur.pn * BM + wc * 32 + 8 * fq;
#pragma unroll
            for (int ai = 0; ai < 2; ++ai)
#pragma unroll
                for (int m = 0; m < 4; ++m) {
#pragma unroll
                    for (int bj = 0; bj < 2; ++bj) E.emit(row0 + ai * HALF + m * 16, col0 + bj * HALF, acc[ai][bj][m][0], acc[ai][bj][m][1]);
                    if (m == 3) asm volatile("" ::: "memory"); }
            E.emit(NPR + 16 * cur.pm + fr, col0 + wr * HALF, accx[0], accx[1]);
        }
        if (!has_next) break;
#pragma unroll
        for (int a = 0; a < 2; ++a)
#pragma unroll
            for (int b = 0; b < 2; ++b)
#pragma unroll
                for (int m = 0; m < 4; ++m)
#pragma unroll
                    for (int n = 0; n < 2; ++n) acc[a][b][m][n] = (f32x4){0.f, 0.f, 0.f, 0.f};
        accx[0] = (f32x4){0.f, 0.f, 0.f, 0.f}; accx[1] = accx[0];
        cur = nxt; cA = nA; cB = nB; ++ui;
        cX = (const char*)g.A + ((size_t)NPR + 16 * cur.pm) * K * 2;
    }
    PG8_WAIT_V(0);
    if (wr == 0) PG8_BAR;
    PG8_BAR;
#undef PG8_SA
#undef PG8_SB
#undef PG8_STAGE
#undef PG8_LDA
#undef PG8_LDB
#undef PG8_MMA
#undef PG8_LDX
#undef PG8_XMMA
#undef PG8_XREADY
#undef PG8_WAIT_V
#undef PG8_WAIT_L
#undef PG8_BAR
#undef PG8_SCHED
}
}

__device__ __forceinline__ void cvt_rows(const float* __restrict__ srcA, size_t nA8, const float* __restrict__ srcB, size_t nB8, bf16_t* __restrict__ dst) {
    const size_t n8 = nA8 + nB8;
    for (size_t i = (size_t)blockIdx.x * 512 + threadIdx.x; i < n8; i += (size_t)gridDim.x * 512) {
        const float* s = (i < nA8) ? srcA + i * 8 : srcB + (i - nA8) * 8;
        const f32x4 a = *(const f32x4*)s, b = *(const f32x4*)(s + 4);
        *(u32x4*)(dst + i * 8) = pack8(a, b);
    }
}
__device__ __forceinline__ void tr_tile(const float* __restrict__ src, bf16_t* __restrict__ dst, int R, int C, int idx, LAS float* tile) {
    int tid_ = threadIdx.x; asm volatile("" : "+v"(tid_));
    const int tid = tid_, ntc = C >> 6, tr = idx / ntc, tc = idx - tr * ntc;
#pragma unroll
    for (int i = 0; i < 2; ++i) { const int e = tid + 512 * i, row = e >> 4, c4 = e & 15;
        const f32x4 v = *(const f32x4*)(src + (size_t)(tr * 64 + row) * C + tc * 64 + c4 * 4);
#pragma unroll
        for (int j = 0; j < 4; ++j) tile[row * 65 + c4 * 4 + j] = v[j]; }
    __syncthreads();
    { const int cc = tid >> 3, r0 = (tid & 7) * 8; f32x4 a, b;
#pragma unroll
      for (int j = 0; j < 4; ++j) { a[j] = tile[(r0 + j) * 65 + cc]; b[j] = tile[(r0 + 4 + j) * 65 + cc]; }
      *(u32x4*)(dst + (size_t)(tc * 64 + cc) * R + tr * 64 + r0) = pack8(a, b); }
    __syncthreads();
}
__device__ __forceinline__ void tr_tile_wide(const float* __restrict__ src, bf16_t* __restrict__ dst, int R, int C, int idx, LAS float* tile) {
    int tid_ = threadIdx.x; asm volatile("" : "+v"(tid_));
    const int tid = tid_, ntc = C >> 8, tr = idx / ntc, tc = idx - tr * ntc;
    f32x4 v[8];
#pragma unroll
    for (int i = 0; i < 8; ++i) { const int e = tid + 512 * i, c4 = e & 15, row = (e >> 4) & 63, sub = e >> 10;
        v[i] = *(const f32x4*)(src + (size_t)(tr * 64 + row) * C + tc * 256 + sub * 64 + c4 * 4); }
#pragma unroll
    for (int i = 0; i < 8; ++i) { const int e = tid + 512 * i, c4 = e & 15, row = (e >> 4) & 63, sub = e >> 10;
#pragma unroll
        for (int j = 0; j < 4; ++j) tile[row * 257 + sub * 64 + c4 * 4 + j] = v[i][j]; }
    __syncthreads();
#pragma unroll
    for (int i = 0; i < 4; ++i) { const int item = tid + 512 * i, cc = item >> 3, r0 = (item & 7) * 8; f32x4 a, b;
#pragma unroll
        for (int j = 0; j < 4; ++j) { a[j] = tile[(r0 + j) * 257 + cc]; b[j] = tile[(r0 + 4 + j) * 257 + cc]; }
        *(u32x4*)(dst + (size_t)(tc * 256 + cc) * R + tr * 64 + r0) = pack8(a, b); }
    __syncthreads();
}
__device__ __forceinline__ void phase0(LAS unsigned char* lds) {
    const CAS Params& P = kparams();
    unsigned char* ws = P.ws;
    LAS float* tile = (LAS float*)lds;
    constexpr int T_IN = 32 * 24, T_SQ = 32 * 8, T_WP = 4 * 8, T_HD = 4;
    constexpr int E0 = 2 * T_IN, E1 = E0 + 2 * T_SQ, E2 = E1 + 2 * T_SQ, E3 = E2 + 2 * T_WP, E4 = E3 + 16 * T_HD, E5 = E4 + 16 * T_HD;
    for (int T = blockIdx.x; T < E5; T += gridDim.x) {
        if (T < E0) { const int l = T / T_IN, i = T - l * T_IN; tr_tile_wide(P.in[7] + (size_t)l * DM * NIN, (bf16_t*)(ws + WS_WIN) + (size_t)l * NIN * DM, DM, NIN, i, tile); }
        else if (T < E1) { const int t = T - E0, l = t / T_SQ, i = t - l * T_SQ; tr_tile_wide(P.in[18] + (size_t)l * DM * DM, (bf16_t*)(ws + WS_WOUT) + (size_t)l * DM * DM, DM, DM, i, tile); }
        else if (T < E2) { const int t = T - E1, l = t / T_SQ, i = t - l * T_SQ; tr_tile_wide(P.in[20] + (size_t)l * DM * DM, (bf16_t*)(ws + WS_WG) + (size_t)l * DM * DM, DM, DM, i, tile); }
        else if (T < E3) { const int t = T - E2, l = t / T_WP, i = t - l * T_WP; tr_tile_wide(P.in[19] + (size_t)l * DPLE * DM, (bf16_t*)(ws + WS_WP) + (size_t)l * DM * DPLE, DPLE, DM, i, tile); }
        else if (T < E4) { const int t = T - E3, mtx = t >> 2, i = t & 3; tr_tile(P.in[10] + (size_t)mtx * 16384, (bf16_t*)(ws + WS_WA) + (size_t)mtx * 16384, 128, 128, i, tile); }
        else { const int t = T - E4, mtx = t >> 2, i = t & 3; tr_tile(P.in[12] + (size_t)mtx * 16384, (bf16_t*)(ws + WS_WX) + (size_t)mtx * 16384, 128, 128, i, tile); }
    }
    cvt_rows(P.in[0], (size_t)NPR * DM / 8, P.in[1], (size_t)NSR * DM / 8, (bf16_t*)(ws + WS_XB));
    for (int l = 0; l < NLAYER; ++l)
        cvt_rows(P.in[5] + (size_t)l * NPR * DPLE, (size_t)NPR * DPLE / 8, P.in[6] + (size_t)l * NSR * DPLE, (size_t)NSR * DPLE / 8, (bf16_t*)(ws + WS_PB) + (size_t)l * MT * DPLE);
}

constexpr int N_LRU_TILES = 4 * 32 * 8 + 8 * 8;
__device__ __forceinline__ void phase2a(int l, LAS unsigned char* lds) {
    const CAS Params& P = kparams();
    int tid_ = threadIdx.x; asm volatile("" : "+v"(tid_));
    const int tid = tid_, lane = tid & 63, wid = tid >> 6, fr = lane & 15, fq = lane >> 4;
    LAS bf16_t* xcA = (LAS bf16_t*)lds;
    LAS float* xcF = (LAS float*)(lds + 17408);
    LAS float* aL = (LAS float*)(lds + 17408 + 33792);
    LAS float* uL = aL + 64 * 128;
    LAS float* subA = uL + 64 * 128;
    LAS float* subH = subA + 512;
    const bf16_t* z = (const bf16_t*)(P.ws + WS_Z);
    float* hlb = (float*)(P.ws + WS_HL); float* ppb = (float*)(P.ws + WS_PP); float* summ = (float*)(P.ws + WS_SUM);
    const float* cw = P.in[8] + (size_t)l * 4 * DL; const float* cb = P.in[9] + (size_t)l * DL;
    for (int tile = blockIdx.x; tile < N_LRU_TILES; tile += gridDim.x) {
        const bool smp = tile >= 1024;
        int b = 0, hd, c;
        if (!smp) { hd = tile & 7; c = (tile >> 3) & 31; b = tile >> 8; } else { const int s = tile - 1024; hd = s & 7; c = s >> 3; }
        const int row0 = smp ? NPR + c * 64 : b * SEQ + c * 64;
        {
            const int g = tid & 15, chl = g * 8, ch0 = hd * 128 + chl;
            f32x4 w[4][2], bias[2];
#pragma unroll
            for (int k = 0; k < 4; ++k) { w[k][0] = *(const f32x4*)(cw + k * DL + ch0); w[k][1] = *(const f32x4*)(cw + k * DL + ch0 + 4); }
            bias[0] = *(const f32x4*)(cb + ch0); bias[1] = *(const f32x4*)(cb + ch0 + 4);
#pragma unroll
            for (int it = 0; it < 2; ++it) {
                const int r = (tid >> 4) + it * 32;
                f32x4 a0 = bias[0], a1 = bias[1];
#pragma unroll
                for (int k = 0; k < 4; ++k) {
                    f32x4 x0, x1; bool have = true, fromz = true; int tt;
                    if (!smp) { tt = c * 64 + r - k; have = tt >= 0; } else { tt = (r & 3) - k; fromz = tt >= 0; }
                    if (!have) { x0 = (f32x4){0.f, 0.f, 0.f, 0.f}; x1 = x0; }
                    else if (fromz) { const u32x4 v = *(const u32x4*)(z + (size_t)(row0 + r - k) * NIN + ch0); UNPACK8(v, x0, x1); }
                    else { const int sq = c * 16 + (r >> 2); const float* sp = P.in[3] + ((size_t)(l * DB + sq) * 3 + (3 + tt)) * DL + ch0; x0 = *(const f32x4*)sp; x1 = *(const f32x4*)(sp + 4); }
                    a0 += w[3 - k][0] * x0; a1 += w[3 - k][1] * x1;
                    if (k == 0) {
                        if (!smp) { if (c == 31 && r >= 61) { float* o = P.out + O_LC_P + ((size_t)(l * NB + b) * 3 + (r - 61)) * DL + ch0; *(f32x4*)o = x0; *(f32x4*)(o + 4) = x1; } }
                        else if ((r & 3) >= 1) { const int sq = c * 16 + (r >> 2); float* o = P.out + O_LC_S + ((size_t)(l * DB + sq) * 3 + ((r & 3) - 1)) * DL + ch0; *(f32x4*)o = x0; *(f32x4*)(o + 4) = x1; }
                    }
                }
                *(LAS f32x4*)(xcF + r * 132 + chl) = a0; *(LAS f32x4*)(xcF + r * 132 + chl + 4) = a1;
                *(LAS u32x4*)(xcA + r * 136 + chl) = pack8(a0, a1);
            }
        }
        __syncthreads();
        {
            const int n0 = wid * 16, chl = n0 + fr, chg = hd * 128 + chl;
            const bf16_t* waT = (const bf16_t*)(P.ws + WS_WA) + ((size_t)((l * 8 + hd) * 128 + chl)) * 128 + fq * 8;
            const bf16_t* wxT = (const bf16_t*)(P.ws + WS_WX) + ((size_t)((l * 8 + hd) * 128 + chl)) * 128 + fq * 8;
            bf16x8 fa[4], fx[4];
#pragma unroll
            for (int kk = 0; kk < 4; ++kk) { fa[kk] = *(const bf16x8*)(waT + kk * 32); fx[kk] = *(const bf16x8*)(wxT + kk * 32); }
            f32x4 accR[4], accI[4];
#pragma unroll
            for (int m = 0; m < 4; ++m) { accR[m] = (f32x4){0.f, 0.f, 0.f, 0.f}; accI[m] = accR[m]; }
#pragma unroll
            for (int m = 0; m < 4; ++m)
#pragma unroll
                for (int kk = 0; kk < 4; ++kk) {
                    const bf16x8 a = *(const LAS bf16x8*)(xcA + (m * 16 + fr) * 136 + kk * 32 + fq * 8);
                    accR[m] = __builtin_amdgcn_mfma_f32_16x16x32_bf16(a, fa[kk], accR[m], 0, 0, 0);
                    accI[m] = __builtin_amdgcn_mfma_f32_16x16x32_bf16(a, fx[kk], accI[m], 0, 0, 0);
                }
            const float ba = P.in[11][l * DL + chg], bx = P.in[13][l * DL + chg], lam = P.in[14][l * DL + chg];
            const float sp = log1pf(expf(-lam));
#pragma unroll
            for (int m = 0; m < 4; ++m)
#pragma unroll
                for (int j = 0; j < 4; ++j) {
                    const int row = m * 16 + fq * 4 + j;
                    const float rr = sigmoidf_(accR[m][j] + ba), ii = sigmoidf_(accI[m][j] + bx);
                    const float la = -8.0f * rr * sp, a = __expf(la), x2 = 2.0f * la;
                    const float ser = -x2 * (1.0f + x2 * (0.5f + x2 * (0.16666667f + x2 * 0.041666668f)));
                    const float om = (x2 > -0.125f) ? ser : (1.0f - a) * (1.0f + a);
                    const float mult = __builtin_amdgcn_sqrtf(fmaxf(om, 0.0f));
                    aL[row * 128 + chl] = a; uL[row * 128 + chl] = mult * ii * xcF[row * 132 + chl];
                }
        }
        __syncthreads();
        {
            const int ch = tid & 127, sub = tid >> 7, chg = hd * 128 + ch;
            if (!smp) {
                float h = 0.f, pr = 1.f;
#pragma unroll 4
                for (int s = 0; s < 16; ++s) { const int t = sub * 16 + s; const float a = aL[t * 128 + ch], u = uL[t * 128 + ch]; h = a * h + u; pr *= a; uL[t * 128 + ch] = h; aL[t * 128 + ch] = pr; }
                subA[sub * 128 + ch] = pr; subH[sub * 128 + ch] = h;
                __syncthreads();
                float carry = 0.f, pref = 1.f;
                for (int j = 0; j < sub; ++j) { const float A = subA[j * 128 + ch]; carry = A * carry + subH[j * 128 + ch]; pref *= A; }
#pragma unroll 4
                for (int s = 0; s < 16; ++s) { const int t = sub * 16 + s; const size_t o = (size_t)(row0 + t) * DL + chg;
                    hlb[o] = uL[t * 128 + ch] + aL[t * 128 + ch] * carry; ppb[o] = aL[t * 128 + ch] * pref; }
                if (sub == 3) { const float A3 = subA[3 * 128 + ch]; float* so = summ + ((size_t)(b * 32 + c) * DL + chg) * 2; so[0] = pref * A3; so[1] = A3 * carry + subH[3 * 128 + ch]; }
            } else {
#pragma unroll
                for (int q = 0; q < 4; ++q) { const int sl = sub * 4 + q, sq = c * 16 + sl;
                    float h = P.in[2][(size_t)(l * DB + sq) * DL + chg];
#pragma unroll
                    for (int t = 0; t < 4; ++t) { const int r = sl * 4 + t; h = aL[r * 128 + ch] * h + uL[r * 128 + ch]; const size_t o = (size_t)(row0 + r) * DL + chg; hlb[o] = h; ppb[o] = 0.f; }
                    P.out[O_LH_S + (size_t)(l * DB + sq) * DL + chg] = h; }
            }
        }
        __syncthreads();
    }
}

__device__ __forceinline__ void phase2c(int l, LAS unsigned char* lds) {
    const CAS Params& P = kparams();
    int tid_ = threadIdx.x; asm volatile("" : "+v"(tid_));
    const int tid = tid_;
    LAS float* carryL = (LAS float*)lds;
    LAS float* partL = carryL + 128;
    const bf16_t* z = (const bf16_t*)(P.ws + WS_Z);
    const float* hlb = (const float*)(P.ws + WS_HL); const float* ppb = (const float*)(P.ws + WS_PP); const float* summ = (const float*)(P.ws + WS_SUM);
    bf16_t* ymix = (bf16_t*)(P.ws + WS_YMIX);
    for (int tile2 = blockIdx.x; tile2 < 2 * N_LRU_TILES; tile2 += gridDim.x) {
        const bool is_sc = tile2 >= N_LRU_TILES; const int tile = is_sc ? tile2 - N_LRU_TILES : tile2;
        const bool smp = tile >= 1024;
        int b = 0, hd, c;
        if (!smp) { hd = tile & 7; c = (tile >> 3) & 31; b = tile >> 8; } else { const int s = tile - 1024; hd = s & 7; c = s >> 3; }
        const int row0 = smp ? NPR + c * 64 : b * SEQ + c * 64;
        const int g = tid & 15, chl = g * 8, ch0 = hd * 128 + chl;
        if (!is_sc) {
            {
                const int ch = tid & 127, part = tid >> 7, chg = hd * 128 + ch; float A = 1.f, H = 0.f;
                if (!smp) {
                    typedef float f32x2 __attribute__((ext_vector_type(2)));
                    f32x2 sv[8];
#pragma unroll
                    for (int jj = 0; jj < 8; ++jj) { const int j = part * 8 + jj, jl = j < c ? j : 0; sv[jj] = *(const f32x2*)(summ + ((size_t)(b * 32 + jl) * DL + chg) * 2); }
#pragma unroll
                    for (int jj = 0; jj < 8; ++jj) { const bool on = part * 8 + jj < c; const float sa = on ? sv[jj][0] : 1.f, sh = on ? sv[jj][1] : 0.f; H = sa * H + sh; A *= sa; }
                }
                partL[tid] = A; partL[512 + tid] = H;
                __syncthreads();
                if (tid < 128) { float carry = 0.f;
#pragma unroll
                    for (int p = 0; p < 4; ++p) carry = partL[p * 128 + tid] * carry + partL[512 + p * 128 + tid];
                    carryL[tid] = carry; }
            }
            __syncthreads();
            const f32x4 c0 = *(const LAS f32x4*)(carryL + chl), c1 = *(const LAS f32x4*)(carryL + chl + 4);
            const f32x4 gn0 = *(const f32x4*)(P.in[16] + l * DL + ch0), gn1 = *(const f32x4*)(P.in[16] + l * DL + ch0 + 4);
#pragma unroll
            for (int it = 0; it < 2; ++it) {
                const int r = (tid >> 4) + it * 32; const size_t o = (size_t)(row0 + r) * DL + ch0;
                const f32x4 h0 = *(const f32x4*)(hlb + o) + *(const f32x4*)(ppb + o) * c0, h1 = *(const f32x4*)(hlb + o + 4) + *(const f32x4*)(ppb + o + 4) * c1;
                const u32x4 gw = *(const u32x4*)(z + (size_t)(row0 + r) * NIN + DL + ch0); f32x4 g0, g1; UNPACK8(gw, g0, g1);
                f32x4 y0, y1; float ss = 0.f;
#pragma unroll
                for (int j = 0; j < 4; ++j) { y0[j] = h0[j] * g0[j] * sigmoidf_(g0[j]); y1[j] = h1[j] * g1[j] * sigmoidf_(g1[j]); ss += y0[j] * y0[j] + y1[j] * y1[j]; }
                ss += __shfl_xor(ss, 1); ss += __shfl_xor(ss, 2); ss += __shfl_xor(ss, 4); ss += __shfl_xor(ss, 8);
                const float sc = rsqrtf(ss * (1.0f / 128.0f) + 1e-6f);
                *(u32x4*)(ymix + (size_t)(row0 + r) * DM + ch0) = pack8(y0 * sc * gn0, y1 * sc * gn1);
                if (!smp && c == 31 && r == 63) { float* oh = P.out + O_LH_P + (size_t)(l * NB + b) * DL + ch0; *(f32x4*)oh = h0; *(f32x4*)(oh + 4) = h1; }
            }
            __syncthreads();
        } else {
            const float* sw = P.in[15] + (size_t)l * 3 * DL;
            f32x4 w[3][2];
#pragma unroll
            for (int k = 0; k < 3; ++k) { w[k][0] = *(const f32x4*)(sw + k * DL + ch0); w[k][1] = *(const f32x4*)(sw + k * DL + ch0 + 4); }
            const f32x4 gn0 = *(const f32x4*)(P.in[17] + l * DL + ch0), gn1 = *(const f32x4*)(P.in[17] + l * DL + ch0 + 4);
#pragma unroll
            for (int it = 0; it < 2; ++it) {
                const int r = (tid >> 4) + it * 32;
                f32x4 v0 = (f32x4){0.f, 0.f, 0.f, 0.f}, v1 = v0;
#pragma unroll
                for (int k = 0; k < 3; ++k) {
                    f32x4 q0, q1; bool have = true, fromz = true; int tt;
                    if (!smp) { tt = c * 64 + r - k; have = tt >= 0; } else { tt = (r & 3) - k; fromz = tt >= 0; }
                    if (!have) { q0 = (f32x4){0.f, 0.f, 0.f, 0.f}; q1 = q0; }
                    else if (fromz) { const bf16_t* zr = z + (size_t)(row0 + r - k) * NIN + ch0; const u32x4 cv = *(const u32x4*)(zr + 3 * DL), hv = *(const u32x4*)(zr + 4 * DL);
                        f32x4 cc0, cc1, hh0, hh1; UNPACK8(cv, cc0, cc1); UNPACK8(hv, hh0, hh1); q0 = cc0 * hh0; q1 = cc1 * hh1; }
                    else { const int sq = c * 16 + (r >> 2); const float* sp = P.in[4] + ((size_t)(l * DB + sq) * 2 + (2 + tt)) * DL + ch0; q0 = *(const f32x4*)sp; q1 = *(const f32x4*)(sp + 4); }
                    v0 += w[2 - k][0] * q0; v1 += w[2 - k][1] * q1;
                    if (k == 0) {
                        if (!smp) { if (c == 31 && r >= 62) { float* o = P.out + O_SC_P + ((size_t)(l * NB + b) * 2 + (r - 62)) * DL + ch0; *(f32x4*)o = q0; *(f32x4*)(o + 4) = q1; } }
                        else if ((r & 3) >= 2) { const int sq = c * 16 + (r >> 2); float* o = P.out + O_SC_S + ((size_t)(l * DB + sq) * 2 + ((r & 3) - 2)) * DL + ch0; *(f32x4*)o = q0; *(f32x4*)(o + 4) = q1; }
                    }
                }
                const bf16_t* zr = z + (size_t)(row0 + r) * NIN + ch0;
                const u32x4 bw = *(const u32x4*)(zr + 2 * DL), gw = *(const u32x4*)(zr + 5 * DL);
                f32x4 b0, b1, g0, g1; UNPACK8(bw, b0, b1); UNPACK8(gw, g0, g1);
                f32x4 y0, y1; float ss = 0.f;
#pragma unroll
                for (int j = 0; j < 4; ++j) { y0[j] = b0[j] * v0[j] * g0[j] * sigmoidf_(g0[j]); y1[j] = b1[j] * v1[j] * g1[j] * sigmoidf_(g1[j]); ss += y0[j] * y0[j] + y1[j] * y1[j]; }
                ss += __shfl_xor(ss, 1); ss += __shfl_xor(ss, 2); ss += __shfl_xor(ss, 4); ss += __shfl_xor(ss, 8);
                const float sc = rsqrtf(ss * (1.0f / 128.0f) + 1e-6f);
                *(u32x4*)(ymix + (size_t)(row0 + r) * DM + DL + ch0) = pack8(y0 * sc * gn0, y1 * sc * gn1);
            }
        }
    }
}

__device__ __forceinline__ void phase4(int l) {
    const CAS Params& P = kparams();
    int tid_ = threadIdx.x; asm volatile("" : "+v"(tid_));
    const int lane = tid_ & 63, wv = (blockIdx.x * 512 + tid_) >> 6, nwv = gridDim.x * 8;
    const float* lg = P.in[22] + l * DM; const float* lb = P.in[23] + l * DM;
    bf16_t* xb = (bf16_t*)(P.ws + WS_XB); const bf16_t* tb = (const bf16_t*)(P.ws + WS_YMIX);
    for (int row = wv; row < MT; row += nwv) {
        f32x4 v[8]; float s = 0.f;
#pragma unroll
        for (int i = 0; i < 4; ++i) { const u32x4 w = *(const u32x4*)(tb + (size_t)row * DM + i * 512 + lane * 8); UNPACK8(w, v[2 * i], v[2 * i + 1]); }
#pragma unroll
        for (int i = 0; i < 8; ++i) s += (v[i][0] + v[i][1]) + (v[i][2] + v[i][3]);
#pragma unroll
        for (int o = 32; o >= 1; o >>= 1) s += __shfl_xor(s, o);
        const float mean = s * (1.0f / DM); float q = 0.f;
#pragma unroll
        for (int i = 0; i < 8; ++i) { v[i] = v[i] - mean; q += (v[i][0] * v[i][0] + v[i][1] * v[i][1]) + (v[i][2] * v[i][2] + v[i][3] * v[i][3]); }
#pragma unroll
        for (int o = 32; o >= 1; o >>= 1) q += __shfl_xor(q, o);
        const float rstd = rsqrtf(q * (1.0f / DM) + 1e-5f);
#pragma unroll
        for (int i = 0; i < 4; ++i) { const int col = i * 512 + lane * 8;
            const f32x4 y0 = v[2 * i] * rstd * *(const f32x4*)(lg + col) + *(const f32x4*)(lb + col), y1 = v[2 * i + 1] * rstd * *(const f32x4*)(lg + col + 4) + *(const f32x4*)(lb + col + 4);
            if (l + 1 < NLAYER) *(u32x4*)(xb + (size_t)row * DM + col) = pack8(y0, y1);
            else { float* rp = P.out + (size_t)row * DM + col; *(f32x4*)rp = y0; *(f32x4*)(rp + 4) = y1; } }
    }
}

#define XB_TMO      128
#define XB_XCNT(j)  (256  + 64 * (j))
#define XB_XSUB(j)  (1280 + 64 * (j))
#define XB_XGEN(j)  (2304 + 64 * (j))
#define XB_TOP      3328
#define XB_TOPGEN   3392
#define XCD_BAR_WORDS 3456
#define XB_SPIN_CAP (1u << 18)
__device__ __forceinline__ unsigned xb_ld(unsigned* p)              { return __hip_atomic_load(p, __ATOMIC_RELAXED, __HIP_MEMORY_SCOPE_AGENT); }
__device__ __forceinline__ unsigned xb_add(unsigned* p, unsigned v) { return __hip_atomic_fetch_add(p, v, __ATOMIC_RELAXED, __HIP_MEMORY_SCOPE_AGENT); }
__device__ __forceinline__ unsigned xb_xcc_id() { return (unsigned)__builtin_amdgcn_s_getreg((3 << 11) | 20) & 0xFu; }
#define XB_SPIN(cond, bar) do { unsigned _sp = 0; while (cond) { __builtin_amdgcn_s_sleep(1); \
    if ((++_sp & 255u) == 0u) { if (xb_ld(&(bar)[XB_TMO])) break; if (_sp > XB_SPIN_CAP) { atomicAdd(&(bar)[XB_TMO], 1u); break; } } } } while (0)
struct XcdBarrier { unsigned* bar; unsigned x; volatile LAS unsigned* st; };
__device__ __forceinline__ XcdBarrier xcd_barrier_post(unsigned* bar, volatile LAS unsigned* st) {
    XcdBarrier b; b.bar = bar; b.x = xb_xcc_id(); b.st = st;
    if (threadIdx.x == 0) (void)xb_add(&bar[XB_XCNT(b.x)], 1u);
    return b;
}
__device__ __forceinline__ void xcd_barrier_complete(unsigned* bar, unsigned x, unsigned& nloc, unsigned& nx) {
    const unsigned G = gridDim.x * gridDim.y * gridDim.z;
    unsigned sum, cnt, mine, sp = 0u;
    for (;;) {
        sum = 0u; cnt = 0u; mine = 0u;
#pragma unroll
        for (unsigned j = 0; j < 16; ++j) { const unsigned c = xb_ld(&bar[XB_XCNT(j)]); sum += c; cnt += (c > 0u) ? 1u : 0u; mine = (j == x) ? c : mine; }
        if (sum == G) break;
        __builtin_amdgcn_s_sleep(1);
        if ((++sp & 255u) == 0u) { if (xb_ld(&bar[XB_TMO])) break; if (sp > XB_SPIN_CAP) { atomicAdd(&bar[XB_TMO], 1u); break; } }
    }
    nloc = mine > 0u ? mine : 1u; nx = cnt > 0u ? cnt : 1u;
}
__device__ __forceinline__ void xcd_barrier(const XcdBarrier& b) {
    asm volatile("s_waitcnt vmcnt(0)" ::: "memory");
    __syncthreads();
    if (threadIdx.x == 0) {
        unsigned* bar = b.bar;
        __builtin_amdgcn_s_waitcnt(0);
        unsigned nloc = b.st[0], nx = b.st[1];
        if (nloc == 0u) { xcd_barrier_complete(bar, b.x, nloc, nx); b.st[0] = nloc; b.st[1] = nx; }
        const unsigned old = xb_add(&bar[XB_XSUB(b.x)], 1u);
        const unsigned gen = old / nloc;
        if (old + 1u == (gen + 1u) * nloc) {
            __builtin_amdgcn_fence(__ATOMIC_RELEASE, "agent");
            asm volatile("s_waitcnt vmcnt(0)" ::: "memory");
            const unsigned og = xb_add(&bar[XB_TOP], 1u);
            const unsigned tg = og / nx;
            if (og + 1u == (tg + 1u) * nx) xb_add(&bar[XB_TOPGEN], 1u);
            else XB_SPIN(xb_ld(&bar[XB_TOPGEN]) == tg, bar);
            __builtin_amdgcn_fence(__ATOMIC_ACQUIRE, "agent");
            xb_add(&bar[XB_XGEN(b.x)], 1u);
            asm volatile("s_waitcnt vmcnt(0)" ::: "memory");
        } else {
            XB_SPIN(xb_ld(&bar[XB_XGEN(b.x)]) == gen, bar);
            __builtin_amdgcn_fence(__ATOMIC_ACQUIRE, "agent");
            asm volatile("s_waitcnt vmcnt(0)" ::: "memory");
        }
    }
    __syncthreads();
}

__global__ void __launch_bounds__(512, 2) mega_fwd(Params Pk) {
    extern __shared__ __attribute__((aligned(16))) unsigned char lds_raw[];
    LAS unsigned char* lds = (LAS unsigned char*)lds_raw;
    int ph = 0;
    if (threadIdx.x < 4) ((LAS unsigned*)(lds + 131072))[threadIdx.x] = 0u;
    __syncthreads();
    XcdBarrier xbar = xcd_barrier_post((unsigned*)(Pk.ws + WS_BAR), (volatile LAS unsigned*)(lds + 131072));
#ifndef PROBE_PH
#define PROBE_PH -1
#endif
#define RUN(k) ((k) >= Pk.ph_lo && (k) < Pk.ph_hi)
#define SEAM(k) do { if ((k) + 1 < Pk.ph_hi) xcd_barrier(xbar); } while (0)
#define REPS(k) (((k) == PROBE_PH) ? 2 : 1)
    if (RUN(ph)) { for (int rp = 0; rp < REPS(0); ++rp) { phase0(lds); SEAM(ph); } } ++ph;
#pragma unroll 1
    for (int l = 0; l < NLAYER; ++l) {
        if (RUN(ph)) for (int rp = 0; rp < REPS(1 + (l == 0 ? 0 : 100)); ++rp) {
            const CAS Params& P = kparams(); unsigned char* ws = P.ws;
            { pg8::Gemm g{(const bf16_t*)(ws + WS_XB), (const bf16_t*)(ws + WS_WIN) + (size_t)l * NIN * DM, NPR, NIN, DM};
              pg8::StaticOrder S; S.init(NPR, NIN, gridDim.x, blockIdx.x);
              pg8::EpiBf16 E{(bf16_t*)(ws + WS_Z), NIN};
              pg8::gemm_phase(lds, g, S, E); }
            { pg8::Gemm g{(const bf16_t*)(ws + WS_PB) + (size_t)l * MT * DPLE, (const bf16_t*)(ws + WS_WP) + (size_t)l * DM * DPLE, NPR, DM, DPLE};
              pg8::StaticOrder S; S.init(NPR, DM, gridDim.x, blockIdx.x);
              pg8::EpiBf16 E{(bf16_t*)(ws + WS_E), DM};
              pg8::gemm_phase(lds, g, S, E); }
            SEAM(ph);
        } ++ph;
        if (RUN(ph)) for (int rp = 0; rp < REPS(2 + (l == 0 ? 0 : 100)); ++rp) { phase2a(l, lds); SEAM(ph); } ++ph;
        if (RUN(ph)) for (int rp = 0; rp < REPS(3 + (l == 0 ? 0 : 100)); ++rp) { phase2c(l, lds); SEAM(ph); } ++ph;
        if (RUN(ph)) for (int rp = 0; rp < REPS(4 + (l == 0 ? 0 : 100)); ++rp) {
            const CAS Params& P = kparams(); unsigned char* ws = P.ws;
            pg8::Gemm g{(const bf16_t*)(ws + WS_YMIX), (const bf16_t*)(ws + WS_WOUT) + (size_t)l * DM * DM, NPR, DM, DM};
            pg8::StaticOrder S; S.init(NPR, DM, gridDim.x, blockIdx.x);
            pg8::EpiRes E{(const bf16_t*)(ws + WS_XB), (bf16_t*)(ws + WS_RB)};
            pg8::gemm_phase(lds, g, S, E);
            SEAM(ph);
        } ++ph;
        if (RUN(ph)) for (int rp = 0; rp < REPS(5 + (l == 0 ? 0 : 100)); ++rp) {
            const CAS Params& P = kparams(); unsigned char* ws = P.ws;
            pg8::Gemm g{(const bf16_t*)(ws + WS_RB), (const bf16_t*)(ws + WS_WG) + (size_t)l * DM * DM, NPR, DM, DM};
            pg8::StaticOrder S; S.init(NPR, DM, gridDim.x, blockIdx.x);
            pg8::EpiGate E{(const bf16_t*)(ws + WS_RB), (const bf16_t*)(ws + WS_E), P.in[21] + l * DM, (bf16_t*)(ws + WS_YMIX)};
            pg8::gemm_phase(lds, g, S, E);
            SEAM(ph);
        } ++ph;
        if (RUN(ph)) for (int rp = 0; rp < REPS(6 + (l == 0 ? 0 : 100)); ++rp) { phase4(l); SEAM(ph); } ++ph;
    }
}
constexpr int N_PHASES = 1 + 6 * NLAYER;
constexpr int LDS_BYTES = 131072 + 16;

extern "C" void kernel_launch(void* const* d_in, const int* in_sizes, int n_in, void* d_out, int out_size, void* d_ws, size_t ws_size, hipStream_t stream) {
    static int grid = 0;
    if (grid == 0) {
        if (n_in != 24 || ws_size < WS_END) { fprintf(stderr, "kernel_launch: need 24 inputs and >= %zu bytes of workspace (got %d, %zu)\n", (size_t)WS_END, n_in, ws_size); grid = -1; return; }
        int dev = 0, cus = 0, per_cu = 0;
        hipGetDevice(&dev); hipDeviceGetAttribute(&cus, hipDeviceAttributeMultiprocessorCount, dev);
        if (hipFuncSetAttribute((const void*)mega_fwd, hipFuncAttributeMaxDynamicSharedMemorySize, LDS_BYTES) != hipSuccess) { fprintf(stderr, "kernel_launch: hipFuncSetAttribute failed\n"); grid = -1; return; }
        if (hipOccupancyMaxActiveBlocksPerMultiprocessor(&per_cu, (const void*)mega_fwd, 512, LDS_BYTES) != hipSuccess || per_cu < 1) { fprintf(stderr, "kernel_launch: occupancy query failed (%d)\n", per_cu); grid = -1; return; }
        grid = cus * per_cu;
        fprintf(stderr, "kernel_launch: grid %d (%d CUs x %d)\n", grid, cus, per_cu);
    }
    if (grid < 0) return;
    if (hipMemsetAsync((char*)d_ws + WS_BAR, 0, XCD_BAR_WORDS * 4, stream) != hipSuccess) { fprintf(stderr, "kernel_launch: memset failed\n"); return; }
    Params p{};
    for (int i = 0; i < 24; ++i) p.in[i] = (const float*)d_in[i];
    p.out = (float*)d_out; p.ws = (unsigned char*)d_ws; p.ph_lo = 0; p.ph_hi = N_PHASES;
    void* args[] = {&p};
    hipError_t e = hipLaunchCooperativeKernel((const void*)mega_fwd, dim3(grid), dim3(512), args, LDS_BYTES, stream);
    if (e != hipSuccess) fprintf(stderr, "kernel_launch: cooperative launch failed: %s (grid %d)\n", hipGetErrorString(e), grid);
}
```

```cpp
#include <hip/hip_runtime.h>
#include <hip/hip_cooperative_groups.h>
#include <cstdio>
namespace cg = cooperative_groups;

#define LAS __attribute__((address_space(3)))
typedef unsigned short bf16_t;
typedef short bf16x8 __attribute__((ext_vector_type(8)));
typedef float f32x4 __attribute__((ext_vector_type(4)));
typedef unsigned u32x4 __attribute__((ext_vector_type(4)));
typedef unsigned u32x2 __attribute__((ext_vector_type(2)));

constexpr int DM = 2048, NPR = 8192, NSR = 512, MT = 8704, NLAYER = 2, DL = 1024, NIN = 6144, DPLE = 256, SEQ = 2048, NB = 4, DB = 128;
constexpr float ALPHA = 1.4142135623730951f;
constexpr size_t O_Y = 0, O_LH_P = (size_t)MT * DM, O_LC_P = O_LH_P + 2 * 4 * 1024, O_SC_P = O_LC_P + 2 * 4 * 3 * 1024,
                 O_LH_S = O_SC_P + 2 * 4 * 2 * 1024, O_LC_S = O_LH_S + 2 * 128 * 1024, O_SC_S = O_LC_S + 2 * 128 * 3 * 1024;
constexpr size_t SZ_ACT = (size_t)MT * DM * 2;
constexpr size_t WS_XB = 0, WS_PB = WS_XB + SZ_ACT, WS_WIN = WS_PB + (size_t)2 * MT * 256 * 2, WS_WOUT = WS_WIN + (size_t)2 * NIN * DM * 2,
                 WS_WG = WS_WOUT + (size_t)2 * DM * DM * 2, WS_WP = WS_WG + (size_t)2 * DM * DM * 2, WS_WA = WS_WP + (size_t)2 * DM * 256 * 2,
                 WS_WX = WS_WA + 524288, WS_SUM = WS_WX + 524288, WS_Z = WS_SUM + 1048576, WS_HL = WS_Z + (size_t)MT * NIN * 2,
                 WS_PP = WS_HL + SZ_ACT, WS_YMIX = WS_PP + SZ_ACT, WS_E = WS_YMIX + SZ_ACT, WS_BAR = WS_E + SZ_ACT, WS_END = WS_BAR + 16384;
constexpr size_t WS_RB = WS_HL;

struct Params { const float* in[24]; float* out; unsigned char* ws; int ph_lo, ph_hi; };
#define CAS __attribute__((address_space(4)))
__device__ __forceinline__ const CAS Params& kparams() { const CAS Params* p = (const CAS Params*)__builtin_amdgcn_kernarg_segment_ptr(); asm volatile("" : "+s"(p)); return *p; }

__device__ __forceinline__ unsigned cvt_pk_bf16(float lo, float hi) { unsigned r; asm volatile("v_cvt_pk_bf16_f32 %0, %1, %2" : "=v"(r) : "v"(lo), "v"(hi)); return r; }
__device__ __forceinline__ float bf_lo(unsigned w) { return __uint_as_float(w << 16); }
__device__ __forceinline__ float bf_hi(unsigned w) { return __uint_as_float(w & 0xffff0000u); }
__device__ __forceinline__ float sigmoidf_(float x) { return __builtin_amdgcn_rcpf(1.0f + __expf(-x)); }
__device__ __forceinline__ u32x4 pack8(const f32x4 a, const f32x4 b) { u32x4 w; w.x = cvt_pk_bf16(a[0], a[1]); w.y = cvt_pk_bf16(a[2], a[3]); w.z = cvt_pk_bf16(b[0], b[1]); w.w = cvt_pk_bf16(b[2], b[3]); return w; }
__device__ __forceinline__ void unpack8_(const u32x4 q, f32x4& lo, f32x4& hi) { lo = (f32x4){bf_lo(q[0]), bf_hi(q[0]), bf_lo(q[1]), bf_hi(q[1])}; hi = (f32x4){bf_lo(q[2]), bf_hi(q[2]), bf_lo(q[3]), bf_hi(q[3])}; }
#define UNPACK8(q_, lo_, hi_) unpack8_(q_, lo_, hi_)

namespace pg8 {
constexpr int BM = 256, BK = 64, HALF = 128, HTB = HALF * BK * 2, STAGE_BYTES = 8 * HTB, NXCD = 8, WGM = 8;
__host__ __device__ __forceinline__ int lds_byte(int r, int c) { const int st = (r >> 4) * 2 + (c >> 5), rr = r & 15, cc = c & 31, ob = rr * 64 + cc * 2; return st * 1024 + (ob ^ (((ob >> 9) & 1) << 5)); }
__host__ __device__ __forceinline__ void stage_rc(int b, int& R, int& C) { const int st = b / 1024, sb = b % 1024, swz = sb ^ (((sb >> 9) & 1) << 5); R = (st >> 1) * 16 + swz / 64; C = (st & 1) * 32 + (swz % 64) / 2; }
__host__ __device__ __forceinline__ int perm32(int rho) { const int n = rho >> 4, i = rho & 15; return 8 * (i >> 2) + 4 * n + (i & 3); }
struct Unit { int pm, pn; };
struct Gemm { const bf16_t* A; const bf16_t* Bt; int M, N, K; };
struct StaticOrder {
    int nM, nN, nwg, G, c;
    __device__ void init(int M, int N, int G_, int c_) { nM = M / BM; nN = N / BM; nwg = nM * nN; G = G_; c = c_; }
    __device__ bool next(int i, Unit& u) const {
        const long L = (long)i * G + c; if (L >= nwg || c < 0) return false;
        int wgid = (int)L; { const int q = nwg / NXCD, r = nwg % NXCD, xcd = wgid % NXCD, off = wgid / NXCD; wgid = (xcd < r ? xcd * (q + 1) : r * (q + 1) + (xcd - r) * q) + off; }
        const int nig = WGM * nN, gid = wgid / nig, fm = gid * WGM, gsz = (nM - fm) < WGM ? (nM - fm) : WGM;
        u.pm = fm + ((wgid % nig) % gsz); u.pn = (wgid % nig) / gsz; return true;
    }
};
struct EpiBf16 {
    bf16_t* O; int ldc;
    __device__ __forceinline__ void emit(int row, int col, const f32x4 v0, const f32x4 v1) const { *(u32x4*)(O + (size_t)row * ldc + col) = pack8(v0, v1); }
};
struct EpiRes {
    const bf16_t* xb; bf16_t* rb;
    __device__ __forceinline__ void emit(int row, int col, const f32x4 v0, const f32x4 v1) const {
        const size_t off = (size_t)row * DM + col; const u32x4 xw = *(const u32x4*)(xb + off); f32x4 x0, x1; UNPACK8(xw, x0, x1);
        *(u32x4*)(rb + off) = pack8(v0 + ALPHA * x0, v1 + ALPHA * x1); }
};
struct EpiGate {
    const bf16_t* rb; const bf16_t* e; const float* bg; bf16_t* tb;
    __device__ __forceinline__ void emit(int row, int col, const f32x4 v0, const f32x4 v1) const {
        const size_t off = (size_t)row * DM + col;
        const u32x4 rw = *(const u32x4*)(rb + off), ew = *(const u32x4*)(e + off); f32x4 r0, r1, e0, e1; UNPACK8(rw, r0, r1); UNPACK8(ew, e0, e1);
        f32x4 g0 = v0 + *(const f32x4*)(bg + col), g1 = v1 + *(const f32x4*)(bg + col + 4);
#pragma unroll
        for (int j = 0; j < 4; ++j) { g0[j] = sigmoidf_(g0[j]); g1[j] = sigmoidf_(g1[j]); }
        *(u32x4*)(tb + off) = pack8(r0 + g0 * e0, r1 + g1 * e1); }
};

template <class Epi, class Sched>
__device__ __forceinline__ void gemm_phase(LAS unsigned char* lds, const Gemm g, const Sched& S, const Epi& E) {
    int tid_ = threadIdx.x; asm volatile("" : "+v"(tid_));
    const int tid = tid_, wid = __builtin_amdgcn_readfirstlane(tid >> 6), lane = tid & 63, wr = wid >> 2, wc = wid & 3, fr = lane & 15, fq = lane >> 4;
    const int K = g.K, nt = K / BK;
    unsigned voffA, voffB;
    { int R, C; stage_rc(tid * 16, R, C); const int Rb = (R & ~31) + perm32(R & 31); voffA = (unsigned)(R * K + C) * 2u; voffB = (unsigned)(Rb * K + C) * 2u; }
    const size_t qstep = (size_t)64 * K * 2;
    const size_t kstep = (size_t)(BK * 2);
    const size_t hstep = (size_t)HALF * K * 2;
    const size_t tstep = 2 * hstep;
    const unsigned ldsw = (unsigned)wid * 1024u;
    const int aoff = lds_byte(wr * 64 + fr, fq * 8), boff = lds_byte(wc * 32 + fr, fq * 8);
    const unsigned xoff = (unsigned)(fr * K + fq * 8) * 2u;
#define PG8_SA(b, h) (((b) * 2 + (h)) * HTB)
#define PG8_SB(b, h) ((4 + (b) * 2 + (h)) * HTB)
#define PG8_STAGE(bufoff, gbase, voff) do { _Pragma("unroll") for (int _i = 0; _i < 2; ++_i) \
        __builtin_amdgcn_global_load_lds((const unsigned*)((const char*)(gbase) + _i * qstep + (voff)), (LAS unsigned*)(lds + (bufoff) + ldsw + _i * 8192), 16, 0, 0); } while (0)
#define PG8_LDA(dst, b, h) do { _Pragma("unroll") for (int m = 0; m < 4; ++m) _Pragma("unroll") for (int k = 0; k < 2; ++k) dst[m][k] = *(const LAS bf16x8*)(lds + PG8_SA(b, h) + aoff + m * 2048 + k * 1024); } while (0)
#define PG8_LDB(dst, b, h) do { _Pragma("unroll") for (int n = 0; n < 2; ++n) _Pragma("unroll") for (int k = 0; k < 2; ++k) dst[n][k] = *(const LAS bf16x8*)(lds + PG8_SB(b, h) + boff + n * 2048 + k * 1024); } while (0)
#define PG8_MMA(ai, bj, At, Bt) do { __builtin_amdgcn_s_setprio(1); _Pragma("unroll") for (int m = 0; m < 4; ++m) _Pragma("unroll") for (int n = 0; n < 2; ++n) _Pragma("unroll") for (int k = 0; k < 2; ++k) \
        acc[ai][bj][m][n] = __builtin_amdgcn_mfma_f32_16x16x32_bf16(Bt[n][k], At[m][k], acc[ai][bj][m][n], 0, 0, 0); __builtin_amdgcn_s_setprio(0); } while (0)
#define PG8_LDX(kt) do { const char* _x = cX + (size_t)(kt) * kstep; \
        asm volatile("global_load_dwordx4 %0, %2, %3\n\tglobal_load_dwordx4 %1, %2, %3 offset:64" : "=&v"(ax[0]), "=&v"(ax[1]) : "v"(xoff), "s"(_x) : "memory"); } while (0)
#define PG8_XREADY() asm volatile("" : "+v"(ax[0]), "+v"(ax[1]))
#define PG8_XMMA() do { if (wr == 0) { _Pragma("unroll") for (int n = 0; n < 2; ++n) _Pragma("unroll") for (int k = 0; k < 2; ++k) accx[n] = __builtin_amdgcn_mfma_f32_16x16x32_bf16(B0[n][k], ax[k], accx[n], 0, 0, 0); } \
        else { _Pragma("unroll") for (int n = 0; n < 2; ++n) _Pragma("unroll") for (int k = 0; k < 2; ++k) accx[n] = __builtin_amdgcn_mfma_f32_16x16x32_bf16(B1[n][k], ax[k], accx[n], 0, 0, 0); } } while (0)
#define PG8_WAIT_V(n) asm volatile("s_waitcnt vmcnt(" #n ")" ::: "memory")
#define PG8_WAIT_L(n) asm volatile("s_waitcnt lgkmcnt(" #n ")" ::: "memory")
#define PG8_BAR __builtin_amdgcn_s_barrier()
#define PG8_SCHED __builtin_amdgcn_sched_barrier(0)
    Unit cur, nxt; int ui = 0;
    if (!S.next(0, cur)) return;
    f32x4 acc[2][2][4][2], accx[2];
#pragma unroll
    for (int a = 0; a < 2; ++a)
#pragma unroll
        for (int b = 0; b < 2; ++b)
#pragma unroll
            for (int m = 0; m < 4; ++m)
#pragma unroll
                for (int n = 0; n < 2; ++n) acc[a][b][m][n] = (f32x4){0.f, 0.f, 0.f, 0.f};
    accx[0] = (f32x4){0.f, 0.f, 0.f, 0.f}; accx[1] = accx[0];
    bf16x8 At[4][2], B0[2][2], B1[2][2], ax[2];
    const char* cA = (const char*)g.A + (size_t)cur.pm * tstep; const char* cB = (const char*)g.Bt + (size_t)cur.pn * tstep;
    const char* cX = (const char*)g.A + ((size_t)NPR + 16 * cur.pm) * K * 2;
    PG8_STAGE(PG8_SB(0, 0), cB, voffB); PG8_STAGE(PG8_SA(0, 0), cA, voffA); PG8_STAGE(PG8_SB(0, 1), cB + hstep, voffB); PG8_STAGE(PG8_SA(0, 1), cA + hstep, voffA);
    if (wr == 1) PG8_BAR;
    PG8_WAIT_V(4); PG8_BAR;
    PG8_STAGE(PG8_SB(1, 0), cB + kstep, voffB); PG8_STAGE(PG8_SA(1, 0), cA + kstep, voffA); PG8_STAGE(PG8_SB(1, 1), cB + hstep + kstep, voffB);
    PG8_WAIT_V(6); PG8_BAR;
    for (;;) {
        const bool has_next = S.next(ui + 1, nxt);
        const char* nA = has_next ? (const char*)g.A + (size_t)nxt.pm * tstep : cA; const char* nB = has_next ? (const char*)g.Bt + (size_t)nxt.pn * tstep : cB;
        for (int t = 0; t < nt; t += 2) {
            const bool last = (t == nt - 2);
            const char* a1 = cA + (size_t)(t + 1) * kstep;
            const char* a2 = last ? nA : cA + (size_t)(t + 2) * kstep; const char* b2 = last ? nB : cB + (size_t)(t + 2) * kstep;
            const char* a3 = a2 + kstep; const char* b3 = b2 + kstep;
            PG8_LDB(B0, 0, 0); PG8_SCHED; PG8_LDA(At, 0, 0); PG8_STAGE(PG8_SA(1, 1), a1 + hstep, voffA); PG8_LDX(t);
            PG8_WAIT_L(8); PG8_BAR; PG8_WAIT_L(0); PG8_MMA(0, 0, At, B0); PG8_BAR; PG8_SCHED;
            PG8_LDB(B1, 0, 1); PG8_STAGE(PG8_SB(0, 0), b2, voffB);
            PG8_BAR; PG8_WAIT_L(0); PG8_MMA(0, 1, At, B1); PG8_BAR;
            PG8_LDA(At, 0, 1); PG8_STAGE(PG8_SA(0, 0), a2, voffA);
            PG8_BAR; PG8_WAIT_L(0); PG8_MMA(1, 0, At, B0); PG8_BAR; PG8_SCHED;
            PG8_STAGE(PG8_SB(0, 1), b2 + hstep, voffB);
            PG8_WAIT_V(6); PG8_XREADY(); PG8_BAR; PG8_MMA(1, 1, At, B1); PG8_XMMA(); PG8_BAR; PG8_SCHED;
            PG8_LDB(B0, 1, 0); PG8_SCHED; PG8_LDA(At, 1, 0); PG8_STAGE(PG8_SA(0, 1), a2 + hstep, voffA); PG8_LDX(t + 1);
            PG8_WAIT_L(8); PG8_BAR; PG8_WAIT_L(0); PG8_MMA(0, 0, At, B0); PG8_BAR; PG8_SCHED;
            PG8_LDB(B1, 1, 1); PG8_STAGE(PG8_SB(1, 0), b3, voffB);
            PG8_BAR; PG8_WAIT_L(0); PG8_MMA(0, 1, At, B1); PG8_BAR;
            PG8_LDA(At, 1, 1); PG8_STAGE(PG8_SA(1, 0), a3, voffA);
            PG8_BAR; PG8_WAIT_L(0); PG8_MMA(1, 0, At, B0); PG8_BAR; PG8_SCHED;
            PG8_STAGE(PG8_SB(1, 1), b3 + hstep, voffB);
            PG8_WAIT_V(6); PG8_XREADY(); PG8_BAR; PG8_MMA(1, 1, At, B1); PG8_XMMA(); PG8_BAR; PG8_SCHED;
        }
        {
            const int row0 = cur.pm * BM + wr * 64 + fr, col0 = cur.pn * BM + wc * 32 + 8 * fq;
#pragma unroll
            for (int ai = 0; ai < 2; ++ai)
#pragma unroll
                for (int m = 0; m < 4; ++m) {
#pragma unroll
                    for (int bj = 0; bj < 2; ++bj) E.emit(row0 + ai * HALF + m * 16, col0 + bj * HALF, acc[ai][bj][m][0], acc[ai][bj][m][1]);
                    if (m == 3) asm volatile("" ::: "memory"); }
            E.emit(NPR + 16 * cur.pm + fr, col0 + wr * HALF, accx[0], accx[1]);
        }
        if (!has_next) break;
#pragma unroll
        for (int a = 0; a < 2; ++a)
#pragma unroll
            for (int b = 0; b < 2; ++b)
#pragma unroll
                for (int m = 0; m < 4; ++m)
#pragma unroll
                    for (int n = 0; n < 2; ++n) acc[a][b][m][n] = (f32x4){0.f, 0.f, 0.f, 0.f};
        accx[0] = (f32x4){0.f, 0.f, 0.f, 0.f}; accx[1] = accx[0];
        cur = nxt; cA = nA; cB = nB; ++ui;
        cX = (const char*)g.A + ((size_t)NPR + 16 * cur.pm) * K * 2;
    }
    PG8_WAIT_V(0);
    if (wr == 0) PG8_BAR;
    PG8_BAR;
#undef PG8_SA
#undef PG8_SB
#undef PG8_STAGE
#undef PG8_LDA
#undef PG8_LDB
#undef PG8_MMA
#undef PG8_LDX
#undef PG8_XMMA
#undef PG8_XREADY
#undef PG8_WAIT_V
#undef PG8_WAIT_L
#undef PG8_BAR
#undef PG8_SCHED
}
}

__device__ __forceinline__ void cvt_rows(const float* __restrict__ srcA, size_t nA8, const float* __restrict__ srcB, size_t nB8, bf16_t* __restrict__ dst) {
    const size_t n8 = nA8 + nB8;
    for (size_t i = (size_t)blockIdx.x * 512 + threadIdx.x; i < n8; i += (size_t)gridDim.x * 512) {
        const float* s = (i < nA8) ? srcA + i * 8 : srcB + (i - nA8) * 8;
        const f32x4 a = *(const f32x4*)s, b = *(const f32x4*)(s + 4);
        *(u32x4*)(dst + i * 8) = pack8(a, b);
    }
}
__device__ __forceinline__ void tr_tile(const float* __restrict__ src, bf16_t* __restrict__ dst, int R, int C, int idx, LAS float* tile) {
    int tid_ = threadIdx.x; asm volatile("" : "+v"(tid_));
    const int tid = tid_, ntc = C >> 6, tr = idx / ntc, tc = idx - tr * ntc;
#pragma unroll
    for (int i = 0; i < 2; ++i) { const int e = tid + 512 * i, row = e >> 4, c4 = e & 15;
        const f32x4 v = *(const f32x4*)(src + (size_t)(tr * 64 + row) * C + tc * 64 + c4 * 4);
#pragma unroll
        for (int j = 0; j < 4; ++j) tile[row * 65 + c4 * 4 + j] = v[j]; }
    __syncthreads();
    { const int cc = tid >> 3, r0 = (tid & 7) * 8; f32x4 a, b;
#pragma unroll
      for (int j = 0; j < 4; ++j) { a[j] = tile[(r0 + j) * 65 + cc]; b[j] = tile[(r0 + 4 + j) * 65 + cc]; }
      *(u32x4*)(dst + (size_t)(tc * 64 + cc) * R + tr * 64 + r0) = pack8(a, b); }
    __syncthreads();
}
__device__ __forceinline__ void tr_tile_wide(const float* __restrict__ src, bf16_t* __restrict__ dst, int R, int C, int idx, LAS float* tile) {
    int tid_ = threadIdx.x; asm volatile("" : "+v"(tid_));
    const int tid = tid_, ntc = C >> 8, tr = idx / ntc, tc = idx - tr * ntc;
    f32x4 v[8];
#pragma unroll
    for (int i = 0; i < 8; ++i) { const int e = tid + 512 * i, c4 = e & 15, row = (e >> 4) & 63, sub = e >> 10;
        v[i] = *(const f32x4*)(src + (size_t)(tr * 64 + row) * C + tc * 256 + sub * 64 + c4 * 4); }
#pragma unroll
    for (int i = 0; i < 8; ++i) { const int e = tid + 512 * i, c4 = e & 15, row = (e >> 4) & 63, sub = e >> 10;
#pragma unroll
        for (int j = 0; j < 4; ++j) tile[row * 257 + sub * 64 + c4 * 4 + j] = v[i][j]; }
    __syncthreads();
#pragma unroll
    for (int i = 0; i < 4; ++i) { const int item = tid + 512 * i, cc = item >> 3, r0 = (item & 7) * 8; f32x4 a, b;
#pragma unroll
        for (int j = 0; j < 4; ++j) { a[j] = tile[(r0 + j) * 257 + cc]; b[j] = tile[(r0 + 4 + j) * 257 + cc]; }
        *(u32x4*)(dst + (size_t)(tc * 256 + cc) * R + tr * 64 + r0) = pack8(a, b); }
    __syncthreads();
}
__device__ __forceinline__ void phase0(LAS unsigned char* lds) {
    const CAS Params& P = kparams();
    unsigned char* ws = P.ws;
    LAS float* tile = (LAS float*)lds;
    constexpr int T_IN = 32 * 24, T_SQ = 32 * 8, T_WP = 4 * 8, T_HD = 4;
    constexpr int E0 = 2 * T_IN, E1 = E0 + 2 * T_SQ, E2 = E1 + 2 * T_SQ, E3 = E2 + 2 * T_WP, E4 = E3 + 16 * T_HD, E5 = E4 + 16 * T_HD;
    for (int T = blockIdx.x; T < E5; T += gridDim.x) {
        if (T < E0) { const int l = T / T_IN, i = T - l * T_IN; tr_tile_wide(P.in[7] + (size_t)l * DM * NIN, (bf16_t*)(ws + WS_WIN) + (size_t)l * NIN * DM, DM, NIN, i, tile); }
        else if (T < E1) { const int t = T - E0, l = t / T_SQ, i = t - l * T_SQ; tr_tile_wide(P.in[18] + (size_t)l * DM * DM, (bf16_t*)(ws + WS_WOUT) + (size_t)l * DM * DM, DM, DM, i, tile); }
        else if (T < E2) { const int t = T - E1, l = t / T_SQ, i = t - l * T_SQ; tr_tile_wide(P.in[20] + (size_t)l * DM * DM, (bf16_t*)(ws + WS_WG) + (size_t)l * DM * DM, DM, DM, i, tile); }
        else if (T < E3) { const int t = T - E2, l = t / T_WP, i = t - l * T_WP; tr_tile_wide(P.in[19] + (size_t)l * DPLE * DM, (bf16_t*)(ws + WS_WP) + (size_t)l * DM * DPLE, DPLE, DM, i, tile); }
        else if (T < E4) { const int t = T - E3, mtx = t >> 2, i = t & 3; tr_tile(P.in[10] + (size_t)mtx * 16384, (bf16_t*)(ws + WS_WA) + (size_t)mtx * 16384, 128, 128, i, tile); }
        else { const int t = T - E4, mtx = t >> 2, i = t & 3; tr_tile(P.in[12] + (size_t)mtx * 16384, (bf16_t*)(ws + WS_WX) + (size_t)mtx * 16384, 128, 128, i, tile); }
    }
    cvt_rows(P.in[0], (size_t)NPR * DM / 8, P.in[1], (size_t)NSR * DM / 8, (bf16_t*)(ws + WS_XB));
    for (int l = 0; l < NLAYER; ++l)
        cvt_rows(P.in[5] + (size_t)l * NPR * DPLE, (size_t)NPR * DPLE / 8, P.in[6] + (size_t)l * NSR * DPLE, (size_t)NSR * DPLE / 8, (bf16_t*)(ws + WS_PB) + (size_t)l * MT * DPLE);
}

constexpr int N_LRU_TILES = 4 * 32 * 8 + 8 * 8;
__device__ __forceinline__ void phase2a(int l, LAS unsigned char* lds) {
    const CAS Params& P = kparams();
    int tid_ = threadIdx.x; asm volatile("" : "+v"(tid_));
    const int tid = tid_, lane = tid & 63, wid = tid >> 6, fr = lane & 15, fq = lane >> 4;
    LAS bf16_t* xcA = (LAS bf16_t*)lds;
    LAS float* xcF = (LAS float*)(lds + 17408);
    LAS float* aL = (LAS float*)(lds + 17408 + 33792);
    LAS float* uL = aL + 64 * 128;
    LAS float* subA = uL + 64 * 128;
    LAS float* subH = subA + 512;
    const bf16_t* z = (const bf16_t*)(P.ws + WS_Z);
    unsigned* hpb = (unsigned*)(P.ws + WS_HL); float* summ = (float*)(P.ws + WS_SUM);
    const float* cw = P.in[8] + (size_t)l * 4 * DL; const float* cb = P.in[9] + (size_t)l * DL;
    for (int tile = blockIdx.x; tile < N_LRU_TILES; tile += gridDim.x) {
        const bool smp = tile >= 1024;
        int b = 0, hd, c;
        if (!smp) { hd = tile & 7; c = (tile >> 3) & 31; b = tile >> 8; } else { const int s = tile - 1024; hd = s & 7; c = s >> 3; }
        const int row0 = smp ? NPR + c * 64 : b * SEQ + c * 64;
        bf16x8 fa[4], fx[4];
        { const bf16_t* waT = (const bf16_t*)(P.ws + WS_WA) + ((size_t)((l * 8 + hd) * 128 + wid * 16 + fr)) * 128 + fq * 8;
          const bf16_t* wxT = (const bf16_t*)(P.ws + WS_WX) + ((size_t)((l * 8 + hd) * 128 + wid * 16 + fr)) * 128 + fq * 8;
#pragma unroll
          for (int kk = 0; kk < 4; ++kk) { fa[kk] = *(const bf16x8*)(waT + kk * 32); fx[kk] = *(const bf16x8*)(wxT + kk * 32); } }
        {
            const int g = tid & 15, chl = g * 8, ch0 = hd * 128 + chl;
            f32x4 w[4][2], bias[2];
#pragma unroll
            for (int k = 0; k < 4; ++k) { w[k][0] = *(const f32x4*)(cw + k * DL + ch0); w[k][1] = *(const f32x4*)(cw + k * DL + ch0 + 4); }
            bias[0] = *(const f32x4*)(cb + ch0); bias[1] = *(const f32x4*)(cb + ch0 + 4);
#pragma unroll
            for (int it = 0; it < 2; ++it) {
                const int r = (tid >> 4) + it * 32;
                f32x4 a0 = bias[0], a1 = bias[1];
#pragma unroll
                for (int k = 0; k < 4; ++k) {
                    f32x4 x0, x1; bool have = true, fromz = true; int tt;
                    if (!smp) { tt = c * 64 + r - k; have = tt >= 0; } else { tt = (r & 3) - k; fromz = tt >= 0; }
                    if (!have) { x0 = (f32x4){0.f, 0.f, 0.f, 0.f}; x1 = x0; }
                    else if (fromz) { const u32x4 v = *(const u32x4*)(z + (size_t)(row0 + r - k) * NIN + ch0); UNPACK8(v, x0, x1); }
                    else { const int sq = c * 16 + (r >> 2); const float* sp = P.in[3] + ((size_t)(l * DB + sq) * 3 + (3 + tt)) * DL + ch0; x0 = *(const f32x4*)sp; x1 = *(const f32x4*)(sp + 4); }
                    a0 += w[3 - k][0] * x0; a1 += w[3 - k][1] * x1;
                    if (k == 0) {
                        if (!smp) { if (c == 31 && r >= 61) { float* o = P.out + O_LC_P + ((size_t)(l * NB + b) * 3 + (r - 61)) * DL + ch0; *(f32x4*)o = x0; *(f32x4*)(o + 4) = x1; } }
                        else if ((r & 3) >= 1) { const int sq = c * 16 + (r >> 2); float* o = P.out + O_LC_S + ((size_t)(l * DB + sq) * 3 + ((r & 3) - 1)) * DL + ch0; *(f32x4*)o = x0; *(f32x4*)(o + 4) = x1; }
                    }
                }
                *(LAS f32x4*)(xcF + r * 132 + chl) = a0; *(LAS f32x4*)(xcF + r * 132 + chl + 4) = a1;
                *(LAS u32x4*)(xcA + r * 136 + chl) = pack8(a0, a1);
            }
        }
        __syncthreads();
        {
            const int n0 = wid * 16, chl = n0 + fr, chg = hd * 128 + chl;
            f32x4 accR[4], accI[4];
#pragma unroll
            for (int m = 0; m < 4; ++m) { accR[m] = (f32x4){0.f, 0.f, 0.f, 0.f}; accI[m] = accR[m]; }
#pragma unroll
            for (int m = 0; m < 4; ++m)
#pragma unroll
                for (int kk = 0; kk < 4; ++kk) {
                    const bf16x8 a = *(const LAS bf16x8*)(xcA + (m * 16 + fr) * 136 + kk * 32 + fq * 8);
                    accR[m] = __builtin_amdgcn_mfma_f32_16x16x32_bf16(a, fa[kk], accR[m], 0, 0, 0);
                    accI[m] = __builtin_amdgcn_mfma_f32_16x16x32_bf16(a, fx[kk], accI[m], 0, 0, 0);
                }
            const float ba = P.in[11][l * DL + chg], bx = P.in[13][l * DL + chg], lam = P.in[14][l * DL + chg];
            const float sp = log1pf(expf(-lam));
#pragma unroll
            for (int m = 0; m < 4; ++m)
#pragma unroll
                for (int j = 0; j < 4; ++j) {
                    const int row = m * 16 + fq * 4 + j;
                    const float rr = sigmoidf_(accR[m][j] + ba), ii = sigmoidf_(accI[m][j] + bx);
                    const float la = -8.0f * rr * sp, a = __expf(la), x2 = 2.0f * la;
                    const float ser = -x2 * (1.0f + x2 * (0.5f + x2 * (0.16666667f + x2 * 0.041666668f)));
                    const float om = (x2 > -0.125f) ? ser : (1.0f - a) * (1.0f + a);
                    const float mult = __builtin_amdgcn_sqrtf(fmaxf(om, 0.0f));
                    aL[row * 128 + chl] = a; uL[row * 128 + chl] = mult * ii * xcF[row * 132 + chl];
                }
        }
        __syncthreads();
        {
            const int ch = tid & 127, sub = tid >> 7, chg = hd * 128 + ch;
            if (!smp) {
                float h = 0.f, pr = 1.f;
#pragma unroll 4
                for (int s = 0; s < 16; ++s) { const int t = sub * 16 + s; const float a = aL[t * 128 + ch], u = uL[t * 128 + ch]; h = a * h + u; pr *= a; uL[t * 128 + ch] = h; aL[t * 128 + ch] = pr; }
                subA[sub * 128 + ch] = pr; subH[sub * 128 + ch] = h;
                __syncthreads();
                float carry = 0.f, pref = 1.f;
                for (int j = 0; j < sub; ++j) { const float A = subA[j * 128 + ch]; carry = A * carry + subH[j * 128 + ch]; pref *= A; }
#pragma unroll 4
                for (int s = 0; s < 16; ++s) { const int t = sub * 16 + s; const size_t o = (size_t)(row0 + t) * DL + chg;
                    hpb[o] = cvt_pk_bf16(uL[t * 128 + ch] + aL[t * 128 + ch] * carry, aL[t * 128 + ch] * pref); }
                if (sub == 3) { const float A3 = subA[3 * 128 + ch]; float* so = summ + ((size_t)(b * 32 + c) * DL + chg) * 2; so[0] = pref * A3; so[1] = A3 * carry + subH[3 * 128 + ch]; }
            } else {
#pragma unroll
                for (int q = 0; q < 4; ++q) { const int sl = sub * 4 + q, sq = c * 16 + sl;
                    float h = P.in[2][(size_t)(l * DB + sq) * DL + chg];
#pragma unroll
                    for (int t = 0; t < 4; ++t) { const int r = sl * 4 + t; h = aL[r * 128 + ch] * h + uL[r * 128 + ch]; const size_t o = (size_t)(row0 + r) * DL + chg; hpb[o] = cvt_pk_bf16(h, 0.f); }
                    P.out[O_LH_S + (size_t)(l * DB + sq) * DL + chg] = h; }
            }
        }
        __syncthreads();
    }
}

__device__ __forceinline__ void phase2c(int l, LAS unsigned char* lds) {
    const CAS Params& P = kparams();
    int tid_ = threadIdx.x; asm volatile("" : "+v"(tid_));
    const int tid = tid_;
    LAS float* carryL = (LAS float*)lds;
    LAS float* partL = carryL + 128;
    const bf16_t* z = (const bf16_t*)(P.ws + WS_Z);
    const unsigned* hpb = (const unsigned*)(P.ws + WS_HL); const float* summ = (const float*)(P.ws + WS_SUM);
    bf16_t* ymix = (bf16_t*)(P.ws + WS_YMIX);
    for (int tile2 = blockIdx.x; tile2 < 2 * N_LRU_TILES; tile2 += gridDim.x) {
        const bool is_sc = tile2 >= N_LRU_TILES; const int tile = is_sc ? tile2 - N_LRU_TILES : tile2;
        const bool smp = tile >= 1024;
        int b = 0, hd, c;
        if (!smp) { hd = tile & 7; c = (tile >> 3) & 31; b = tile >> 8; } else { const int s = tile - 1024; hd = s & 7; c = s >> 3; }
        const int row0 = smp ? NPR + c * 64 : b * SEQ + c * 64;
        const int g = tid & 15, chl = g * 8, ch0 = hd * 128 + chl;
        if (!is_sc) {
            {
                const int ch = tid & 127, part = tid >> 7, chg = hd * 128 + ch; float A = 1.f, H = 0.f;
                if (!smp) {
                    typedef float f32x2 __attribute__((ext_vector_type(2)));
                    f32x2 sv[8];
#pragma unroll
                    for (int jj = 0; jj < 8; ++jj) { const int j = part * 8 + jj, jl = j < c ? j : 0; sv[jj] = *(const f32x2*)(summ + ((size_t)(b * 32 + jl) * DL + chg) * 2); }
#pragma unroll
                    for (int jj = 0; jj < 8; ++jj) { const bool on = part * 8 + jj < c; const float sa = on ? sv[jj][0] : 1.f, sh = on ? sv[jj][1] : 0.f; H = sa * H + sh; A *= sa; }
                }
                partL[tid] = A; partL[512 + tid] = H;
                __syncthreads();
                if (tid < 128) { float carry = 0.f;
#pragma unroll
                    for (int p = 0; p < 4; ++p) carry = partL[p * 128 + tid] * carry + partL[512 + p * 128 + tid];
                    carryL[tid] = carry; }
            }
            __syncthreads();
            const f32x4 c0 = *(const LAS f32x4*)(carryL + chl), c1 = *(const LAS f32x4*)(carryL + chl + 4);
            const f32x4 gn0 = *(const f32x4*)(P.in[16] + l * DL + ch0), gn1 = *(const f32x4*)(P.in[16] + l * DL + ch0 + 4);
#pragma unroll
            for (int it = 0; it < 2; ++it) {
                const int r = (tid >> 4) + it * 32; const size_t o = (size_t)(row0 + r) * DL + ch0;
                const u32x4 hw0 = *(const u32x4*)(hpb + o), hw1 = *(const u32x4*)(hpb + o + 4); f32x4 h0, h1;
#pragma unroll
                for (int j = 0; j < 4; ++j) { h0[j] = bf_lo(hw0[j]) + bf_hi(hw0[j]) * c0[j]; h1[j] = bf_lo(hw1[j]) + bf_hi(hw1[j]) * c1[j]; }
                const u32x4 gw = *(const u32x4*)(z + (size_t)(row0 + r) * NIN + DL + ch0); f32x4 g0, g1; UNPACK8(gw, g0, g1);
                f32x4 y0, y1; float ss = 0.f;
#pragma unroll
                for (int j = 0; j < 4; ++j) { y0[j] = h0[j] * g0[j] * sigmoidf_(g0[j]); y1[j] = h1[j] * g1[j] * sigmoidf_(g1[j]); ss += y0[j] * y0[j] + y1[j] * y1[j]; }
                ss += __shfl_xor(ss, 1); ss += __shfl_xor(ss, 2); ss += __shfl_xor(ss, 4); ss += __shfl_xor(ss, 8);
                const float sc = rsqrtf(ss * (1.0f / 128.0f) + 1e-6f);
                *(u32x4*)(ymix + (size_t)(row0 + r) * DM + ch0) = pack8(y0 * sc * gn0, y1 * sc * gn1);
                if (!smp && c == 31 && r == 63) {
                    const float* so = summ + ((size_t)(b * 32 + 31) * DL + ch0) * 2; float* oh = P.out + O_LH_P + (size_t)(l * NB + b) * DL + ch0;
                    const f32x4 s0 = *(const f32x4*)so, s1 = *(const f32x4*)(so + 4), s2 = *(const f32x4*)(so + 8), s3 = *(const f32x4*)(so + 12);
                    *(f32x4*)oh = (f32x4){s0[1] + s0[0] * c0[0], s0[3] + s0[2] * c0[1], s1[1] + s1[0] * c0[2], s1[3] + s1[2] * c0[3]};
                    *(f32x4*)(oh + 4) = (f32x4){s2[1] + s2[0] * c1[0], s2[3] + s2[2] * c1[1], s3[1] + s3[0] * c1[2], s3[3] + s3[2] * c1[3]}; }
            }
            __syncthreads();
        } else {
            const float* sw = P.in[15] + (size_t)l * 3 * DL;
            f32x4 w[3][2];
#pragma unroll
            for (int k = 0; k < 3; ++k) { w[k][0] = *(const f32x4*)(sw + k * DL + ch0); w[k][1] = *(const f32x4*)(sw + k * DL + ch0 + 4); }
            const f32x4 gn0 = *(const f32x4*)(P.in[17] + l * DL + ch0), gn1 = *(const f32x4*)(P.in[17] + l * DL + ch0 + 4);
#pragma unroll
            for (int it = 0; it < 2; ++it) {
                const int r = (tid >> 4) + it * 32;
                f32x4 v0 = (f32x4){0.f, 0.f, 0.f, 0.f}, v1 = v0;
#pragma unroll
                for (int k = 0; k < 3; ++k) {
                    f32x4 q0, q1; bool have = true, fromz = true; int tt;
                    if (!smp) { tt = c * 64 + r - k; have = tt >= 0; } else { tt = (r & 3) - k; fromz = tt >= 0; }
                    if (!have) { q0 = (f32x4){0.f, 0.f, 0.f, 0.f}; q1 = q0; }
                    else if (fromz) { const bf16_t* zr = z + (size_t)(row0 + r - k) * NIN + ch0; const u32x4 cv = *(const u32x4*)(zr + 3 * DL), hv = *(const u32x4*)(zr + 4 * DL);
                        f32x4 cc0, cc1, hh0, hh1; UNPACK8(cv, cc0, cc1); UNPACK8(hv, hh0, hh1); q0 = cc0 * hh0; q1 = cc1 * hh1; }
                    else { const int sq = c * 16 + (r >> 2); const float* sp = P.in[4] + ((size_t)(l * DB + sq) * 2 + (2 + tt)) * DL + ch0; q0 = *(const f32x4*)sp; q1 = *(const f32x4*)(sp + 4); }
                    v0 += w[2 - k][0] * q0; v1 += w[2 - k][1] * q1;
                    if (k == 0) {
                        if (!smp) { if (c == 31 && r >= 62) { float* o = P.out + O_SC_P + ((size_t)(l * NB + b) * 2 + (r - 62)) * DL + ch0; *(f32x4*)o = q0; *(f32x4*)(o + 4) = q1; } }
                        else if ((r & 3) >= 2) { const int sq = c * 16 + (r >> 2); float* o = P.out + O_SC_S + ((size_t)(l * DB + sq) * 2 + ((r & 3) - 2)) * DL + ch0; *(f32x4*)o = q0; *(f32x4*)(o + 4) = q1; }
                    }
                }
                const bf16_t* zr = z + (size_t)(row0 + r) * NIN + ch0;
                const u32x4 bw = *(const u32x4*)(zr + 2 * DL), gw = *(const u32x4*)(zr + 5 * DL);
                f32x4 b0, b1, g0, g1; UNPACK8(bw, b0, b1); UNPACK8(gw, g0, g1);
                f32x4 y0, y1; float ss = 0.f;
#pragma unroll
                for (int j = 0; j < 4; ++j) { y0[j] = b0[j] * v0[j] * g0[j] * sigmoidf_(g0[j]); y1[j] = b1[j] * v1[j] * g1[j] * sigmoidf_(g1[j]); ss += y0[j] * y0[j] + y1[j] * y1[j]; }
                ss += __shfl_xor(ss, 1); ss += __shfl_xor(ss, 2); ss += __shfl_xor(ss, 4); ss += __shfl_xor(ss, 8);
                const float sc = rsqrtf(ss * (1.0f / 128.0f) + 1e-6f);
                *(u32x4*)(ymix + (size_t)(row0 + r) * DM + DL + ch0) = pack8(y0 * sc * gn0, y1 * sc * gn1);
            }
        }
    }
}

__device__ __forceinline__ void phase4(int l) {
    const CAS Params& P = kparams();
    int tid_ = threadIdx.x; asm volatile("" : "+v"(tid_));
    const int lane = tid_ & 63, wv = (blockIdx.x * 512 + tid_) >> 6, nwv = gridDim.x * 8;
    const float* lg = P.in[22] + l * DM; const float* lb = P.in[23] + l * DM;
    bf16_t* xb = (bf16_t*)(P.ws + WS_XB); const bf16_t* tb = (const bf16_t*)(P.ws + WS_YMIX);
    for (int row = wv; row < MT; row += nwv) {
        f32x4 v[8]; float s = 0.f;
#pragma unroll
        for (int i = 0; i < 4; ++i) { const u32x4 w = *(const u32x4*)(tb + (size_t)row * DM + i * 512 + lane * 8); UNPACK8(w, v[2 * i], v[2 * i + 1]); }
#pragma unroll
        for (int i = 0; i < 8; ++i) s += (v[i][0] + v[i][1]) + (v[i][2] + v[i][3]);
#pragma unroll
        for (int o = 32; o >= 1; o >>= 1) s += __shfl_xor(s, o);
        const float mean = s * (1.0f / DM); float q = 0.f;
#pragma unroll
        for (int i = 0; i < 8; ++i) { v[i] = v[i] - mean; q += (v[i][0] * v[i][0] + v[i][1] * v[i][1]) + (v[i][2] * v[i][2] + v[i][3] * v[i][3]); }
#pragma unroll
        for (int o = 32; o >= 1; o >>= 1) q += __shfl_xor(q, o);
        const float rstd = rsqrtf(q * (1.0f / DM) + 1e-5f);
#pragma unroll
        for (int i = 0; i < 4; ++i) { const int col = i * 512 + lane * 8;
            const f32x4 y0 = v[2 * i] * rstd * *(const f32x4*)(lg + col) + *(const f32x4*)(lb + col), y1 = v[2 * i + 1] * rstd * *(const f32x4*)(lg + col + 4) + *(const f32x4*)(lb + col + 4);
            if (l + 1 < NLAYER) *(u32x4*)(xb + (size_t)row * DM + col) = pack8(y0, y1);
            else { float* rp = P.out + (size_t)row * DM + col; *(f32x4*)rp = y0; *(f32x4*)(rp + 4) = y1; } }
    }
}

#define XB_TMO      128
#define XB_XCNT(j)  (256  + 64 * (j))
#define XB_XSUB(j)  (1280 + 64 * (j))
#define XB_XGEN(j)  (2304 + 64 * (j))
#define XB_TOP      3328
#define XB_TOPGEN   3392
#define XCD_BAR_WORDS 3456
#define XB_SPIN_CAP (1u << 18)
__device__ __forceinline__ unsigned xb_ld(unsigned* p)              { return __hip_atomic_load(p, __ATOMIC_RELAXED, __HIP_MEMORY_SCOPE_AGENT); }
__device__ __forceinline__ unsigned xb_add(unsigned* p, unsigned v) { return __hip_atomic_fetch_add(p, v, __ATOMIC_RELAXED, __HIP_MEMORY_SCOPE_AGENT); }
__device__ __forceinline__ unsigned xb_xcc_id() { return (unsigned)__builtin_amdgcn_s_getreg((3 << 11) | 20) & 0xFu; }
#define XB_SPIN(cond, bar) do { unsigned _sp = 0; while (cond) { __builtin_amdgcn_s_sleep(1); \
    if ((++_sp & 255u) == 0u) { if (xb_ld(&(bar)[XB_TMO])) break; if (_sp > XB_SPIN_CAP) { atomicAdd(&(bar)[XB_TMO], 1u); break; } } } } while (0)
struct XcdBarrier { unsigned* bar; unsigned x; volatile LAS unsigned* st; };
__device__ __forceinline__ XcdBarrier xcd_barrier_post(unsigned* bar, volatile LAS unsigned* st) {
    XcdBarrier b; b.bar = bar; b.x = xb_xcc_id(); b.st = st;
    if (threadIdx.x == 0) (void)xb_add(&bar[XB_XCNT(b.x)], 1u);
    return b;
}
__device__ __forceinline__ void xcd_barrier_complete(unsigned* bar, unsigned x, unsigned& nloc, unsigned& nx) {
    const unsigned G = gridDim.x * gridDim.y * gridDim.z;
    unsigned sum, cnt, mine, sp = 0u;
    for (;;) {
        sum = 0u; cnt = 0u; mine = 0u;
#pragma unroll
        for (unsigned j = 0; j < 16; ++j) { const unsigned c = xb_ld(&bar[XB_XCNT(j)]); sum += c; cnt += (c > 0u) ? 1u : 0u; mine = (j == x) ? c : mine; }
        if (sum == G) break;
        __builtin_amdgcn_s_sleep(1);
        if ((++sp & 255u) == 0u) { if (xb_ld(&bar[XB_TMO])) break; if (sp > XB_SPIN_CAP) { atomicAdd(&bar[XB_TMO], 1u); break; } }
    }
    nloc = mine > 0u ? mine : 1u; nx = cnt > 0u ? cnt : 1u;
}
__device__ __forceinline__ void xcd_barrier(const XcdBarrier& b) {
    asm volatile("s_waitcnt vmcnt(0)" ::: "memory");
    __syncthreads();
    if (threadIdx.x == 0) {
        unsigned* bar = b.bar;
        __builtin_amdgcn_s_waitcnt(0);
        unsigned nloc = b.st[0], nx = b.st[1];
        if (nloc == 0u) { xcd_barrier_complete(bar, b.x, nloc, nx); b.st[0] = nloc; b.st[1] = nx; }
        const unsigned old = xb_add(&bar[XB_XSUB(b.x)], 1u);
        const unsigned gen = old / nloc;
        if (old + 1u == (gen + 1u) * nloc) {
            __builtin_amdgcn_fence(__ATOMIC_RELEASE, "agent");
            asm volatile("s_waitcnt vmcnt(0)" ::: "memory");
            const unsigned og = xb_add(&bar[XB_TOP], 1u);
            const unsigned tg = og / nx;
            if (og + 1u == (tg + 1u) * nx) xb_add(&bar[XB_TOPGEN], 1u);
            else XB_SPIN(xb_ld(&bar[XB_TOPGEN]) == tg, bar);
            __builtin_amdgcn_fence(__ATOMIC_ACQUIRE, "agent");
            xb_add(&bar[XB_XGEN(b.x)], 1u);
            asm volatile("s_waitcnt vmcnt(0)" ::: "memory");
        } else {
            XB_SPIN(xb_ld(&bar[XB_XGEN(b.x)]) == gen, bar);
            __builtin_amdgcn_fence(__ATOMIC_ACQUIRE, "agent");
            asm volatile("s_waitcnt vmcnt(0)" ::: "memory");
        }
    }
    __syncthreads();
}

__global__ void __launch_bounds__(512, 2) mega_fwd(Params Pk) {
    extern __shared__ __attribute__((aligned(16))) unsigned char lds_raw[];
    LAS unsigned char* lds = (LAS unsigned char*)lds_raw;
    int ph = 0;
    if (threadIdx.x < 4) ((LAS unsigned*)(lds + 131072))[threadIdx.x] = 0u;
    __syncthreads();
    XcdBarrier xbar = xcd_barrier_post((unsigned*)(Pk.ws + WS_BAR), (volatile LAS unsigned*)(lds + 131072));
#ifndef PROBE_PH
#define PROBE_PH -1
#endif
#define RUN(k) ((k) >= Pk.ph_lo && (k) < Pk.ph_hi)
#define SEAM(k) do { if ((k) + 1 < Pk.ph_hi) xcd_barrier(xbar); } while (0)
#define REPS(k) (((k) == PROBE_PH) ? 2 : 1)
    if (RUN(ph)) { for (int rp = 0; rp < REPS(0); ++rp) { phase0(lds); SEAM(ph); } } ++ph;
#pragma unroll 1
    for (int l = 0; l < NLAYER; ++l) {
        if (RUN(ph)) for (int rp = 0; rp < REPS(1 + (l == 0 ? 0 : 100)); ++rp) {
            const CAS Params& P = kparams(); unsigned char* ws = P.ws;
            { pg8::Gemm g{(const bf16_t*)(ws + WS_XB), (const bf16_t*)(ws + WS_WIN) + (size_t)l * NIN * DM, NPR, NIN, DM};
              pg8::StaticOrder S; S.init(NPR, NIN, gridDim.x, blockIdx.x);
              pg8::EpiBf16 E{(bf16_t*)(ws + WS_Z), NIN};
              pg8::gemm_phase(lds, g, S, E); }
            { pg8::Gemm g{(const bf16_t*)(ws + WS_PB) + (size_t)l * MT * DPLE, (const bf16_t*)(ws + WS_WP) + (size_t)l * DM * DPLE, NPR, DM, DPLE};
              pg8::StaticOrder S; S.init(NPR, DM, gridDim.x, blockIdx.x);
              pg8::EpiBf16 E{(bf16_t*)(ws + WS_E), DM};
              pg8::gemm_phase(lds, g, S, E); }
            SEAM(ph);
        } ++ph;
        if (RUN(ph)) for (int rp = 0; rp < REPS(2 + (l == 0 ? 0 : 100)); ++rp) { phase2a(l, lds); SEAM(ph); } ++ph;
        if (RUN(ph)) for (int rp = 0; rp < REPS(3 + (l == 0 ? 0 : 100)); ++rp) { phase2c(l, lds); SEAM(ph); } ++ph;
        if (RUN(ph)) for (int rp = 0; rp < REPS(4 + (l == 0 ? 0 : 100)); ++rp) {
            const CAS Params& P = kparams(); unsigned char* ws = P.ws;
            pg8::Gemm g{(const bf16_t*)(ws + WS_YMIX), (const bf16_t*)(ws + WS_WOUT) + (size_t)l * DM * DM, NPR, DM, DM};
            pg8::StaticOrder S; S.init(NPR, DM, gridDim.x, blockIdx.x);
            pg8::EpiRes E{(const bf16_t*)(ws + WS_XB), (bf16_t*)(ws + WS_RB)};
            pg8::gemm_phase(lds, g, S, E);
            SEAM(ph);
        } ++ph;
        if (RUN(ph)) for (int rp = 0; rp < REPS(5 + (l == 0 ? 0 : 100)); ++rp) {
            const CAS Params& P = kparams(); unsigned char* ws = P.ws;
            pg8::Gemm g{(const bf16_t*)(ws + WS_RB), (const bf16_t*)(ws + WS_WG) + (size_t)l * DM * DM, NPR, DM, DM};
            pg8::StaticOrder S; S.init(NPR, DM, gridDim.x, blockIdx.x);
            pg8::EpiGate E{(const bf16_t*)(ws + WS_RB), (const bf16_t*)(ws + WS_E), P.in[21] + l * DM, (bf16_t*)(ws + WS_YMIX)};
            pg8::gemm_phase(lds, g, S, E);
            SEAM(ph);
        } ++ph;
        if (RUN(ph)) for (int rp = 0; rp < REPS(6 + (l == 0 ? 0 : 100)); ++rp) { phase4(l); SEAM(ph); } ++ph;
    }
}
constexpr int N_PHASES = 1 + 6 * NLAYER;
constexpr int LDS_BYTES = 131072 + 16;

extern "C" void kernel_launch(void* const* d_in, const int* in_sizes, int n_in, void* d_out, int out_size, void* d_ws, size_t ws_size, hipStream_t stream) {
    static int grid = 0;
    if (grid == 0) {
        if (n_in != 24 || ws_size < WS_END) { fprintf(stderr, "kernel_launch: need 24 inputs and >= %zu bytes of workspace (got %d, %zu)\n", (size_t)WS_END, n_in, ws_size); grid = -1; return; }
        int dev = 0, cus = 0, per_cu = 0;
        hipGetDevice(&dev); hipDeviceGetAttribute(&cus, hipDeviceAttributeMultiprocessorCount, dev);
        if (hipFuncSetAttribute((const void*)mega_fwd, hipFuncAttributeMaxDynamicSharedMemorySize, LDS_BYTES) != hipSuccess) { fprintf(stderr, "kernel_launch: hipFuncSetAttribute failed\n"); grid = -1; return; }
        if (hipOccupancyMaxActiveBlocksPerMultiprocessor(&per_cu, (const void*)mega_fwd, 512, LDS_BYTES) != hipSuccess || per_cu < 1) { fprintf(stderr, "kernel_launch: occupancy query failed (%d)\n", per_cu); grid = -1; return; }
        grid = cus * per_cu;
        fprintf(stderr, "kernel_launch: grid %d (%d CUs x %d)\n", grid, cus, per_cu);
    }
    if (grid < 0) return;
    if (hipMemsetAsync((char*)d_ws + WS_BAR, 0, XCD_BAR_WORDS * 4, stream) != hipSuccess) { fprintf(stderr, "kernel_launch: memset failed\n"); return; }
    Params p{};
    for (int i = 0; i < 24; ++i) p.in[i] = (const float*)d_in[i];
    p.out = (float*)d_out; p.ws = (unsigned char*)d_ws; p.ph_lo = 0; p.ph_hi = N_PHASES;
    void* args[] = {&p};
    hipError_t e = hipLaunchCooperativeKernel((const void*)mega_fwd, dim3(grid), dim3(512), args, LDS_BYTES, stream);
    if (e != hipSuccess) fprintf(stderr, "kernel_launch: cooperative launch failed: %s (grid %d)\n", hipGetErrorString(e), grid);
}
```
